# Optimizing an MI355X kernel written in HIP

```python
import math
import jax
import jax.numpy as jnp
from jax import lax
import numpy as np

D_MODEL = 1024
BATCH = 16
SEQ = 2048
DEPTH = 2

CTX_LEN = 256
GRID_W = 64
D_MIX = D_MODEL
N_DIR = 2
N_MOD = 6
EPS = 1e-6
M_WIDTH = 512
M_HEADDIM = 64
M_HEADS = M_WIDTH // M_HEADDIM
M_GROUPS = 2
M_STATE = 128
M_CONV = 3
M_CHUNK = 128
M_XBC = M_WIDTH + 2 * M_GROUPS * M_STATE
M_COLS = M_WIDTH + M_XBC + N_DIR * M_HEADS
R_WIDTH = D_MIX - M_WIDTH
R_HEADDIM = 64
R_HEADS = R_WIDTH // R_HEADDIM
R_DECAY_LORA = 64
R_AAA_LORA = 64
R_GATE_LORA = 160
R_LN_EPS = 64e-5
R_DECAY_SCALE = 0.6065306597126334
R_COLS = 3 * R_WIDTH + N_DIR * (R_DECAY_LORA + R_AAA_LORA) + R_GATE_LORA
IN_COLS = M_COLS + R_COLS
D_FF = 2816
FF_CONV = 3

kernel_name = 'hybrid_ssd_rwkv7_convglu_dit_block'


def rms_norm(x, g):
    xf = x.astype(jnp.float32)
    y = xf * lax.rsqrt(jnp.mean(xf * xf, axis=-1, keepdims=True) + EPS)
    return y.astype(x.dtype) * g


def modulate(h, shift, scale):
    return h * (1 + scale) + shift


def flip(t):
    return jnp.flip(t, axis=1)


def dwconv1d(u, w, b):
    y = lax.conv_general_dilated(u, w[:, None, :].astype(u.dtype), (1,), 'SAME',
                                 dimension_numbers=('NWC', 'WIO', 'NWC'),
                                 feature_group_count=u.shape[-1])
    return y + b


def dwconv_grid(u, w, b):
    bsz, length, ch = u.shape
    rows = length // GRID_W
    img = u.reshape(bsz, rows, GRID_W, ch)
    y = lax.conv_general_dilated(img, w[:, :, None, :].astype(u.dtype), (1, 1), 'SAME',
                                 dimension_numbers=('NHWC', 'HWIO', 'NHWC'),
                                 feature_group_count=ch)
    return y.reshape(bsz, length, ch) + b


def centred_shift(u, mu):
    pad = jnp.pad(u, ((0, 0), (1, 1), (0, 0)))
    nb = 0.5 * (pad[:, :-2] + pad[:, 2:])
    return u + mu * (nb - u)


def ssd_chunked(xh, dt, A, Bh, Ch, h0):
    bsz, length, nh, hp = xh.shape
    nc = length // M_CHUNK

    def chunk(t):
        return t.reshape(bsz, nc, M_CHUNK, *t.shape[2:])

    x_c, dt_c, B_c, C_c = chunk(xh), chunk(dt), chunk(Bh), chunk(Ch)
    a_cum = jnp.cumsum(dt_c * A, axis=2)
    lower = jnp.tril(jnp.ones((M_CHUNK, M_CHUNK), dtype=bool))
    seg = a_cum[:, :, :, None, :] - a_cum[:, :, None, :, :]
    decay_ij = jnp.exp(jnp.where(lower[None, None, :, :, None], seg, -jnp.inf))
    scores = jnp.einsum('bcihn,bcjhn->bcijh', C_c, B_c) * decay_ij * dt_c[:, :, None]
    y_diag = jnp.einsum('bcijh,bcjhp->bcihp', scores, x_c)
    decay_end = jnp.exp(a_cum[:, :, -1:, :] - a_cum)
    states = jnp.einsum('bcjhn,bcjh,bcjhp->bchpn', B_c, decay_end * dt_c, x_c)
    chunk_decay = jnp.exp(a_cum[:, :, -1, :])

    def step(h, inp):
        st, dec = inp
        return h * dec[:, :, None, None] + st, h

    h_last, h_in = lax.scan(step, h0, (jnp.moveaxis(states, 1, 0), jnp.moveaxis(chunk_decay, 1, 0)))
    h_in = jnp.moveaxis(h_in, 0, 1)
    y_off = jnp.einsum('bcihn,bchpn->bcihp', C_c, h_in) * jnp.exp(a_cum)[..., None]
    return (y_diag + y_off).reshape(bsz, length, nh, hp), h_last


def wkv7(r, decay, k, v, kk, a, s0):
    def step(s, inp):
        r_t, w_t, k_t, v_t, kk_t, a_t = inp
        sa = jnp.einsum('bhvk,bhk->bhv', s, -kk_t)
        s = s * w_t[:, :, None, :] + sa[..., None] * (kk_t * a_t)[:, :, None, :] + v_t[..., None] * k_t[:, :, None, :]
        return s, jnp.einsum('bhvk,bhk->bhv', s, r_t)

    xs = tuple(jnp.moveaxis(t, 1, 0) for t in (r, decay, k, v, kk, a))
    s_last, o = lax.scan(step, s0, xs)
    return jnp.moveaxis(o, 0, 1), s_last


def mamba_group(z, xbc, dt_raw, conv_w, conv_b, dt_bias, a_log, d_skip, norm_w, h0):
    bsz, length, _ = z.shape
    f32 = jnp.float32
    xbc = jax.nn.silu(dwconv1d(xbc, conv_w, conv_b))
    xs, Bm, Cm = jnp.split(xbc, [M_WIDTH, M_WIDTH + M_GROUPS * M_STATE], axis=-1)
    rep = M_HEADS // M_GROUPS
    xh = xs.reshape(bsz, length, M_HEADS, M_HEADDIM).astype(f32)
    Bh = jnp.repeat(Bm.reshape(bsz, length, M_GROUPS, M_STATE), rep, axis=2).astype(f32)
    Ch = jnp.repeat(Cm.reshape(bsz, length, M_GROUPS, M_STATE), rep, axis=2).astype(f32)
    dt = jax.nn.softplus(dt_raw.reshape(bsz, length, N_DIR, M_HEADS).astype(f32) + dt_bias.astype(f32))
    A = -jnp.exp(a_log.astype(f32))
    y_f, h_f = ssd_chunked(xh, dt[:, :, 0], A[0], Bh, Ch, h0[0])
    y_b, h_b = ssd_chunked(flip(xh), flip(dt[:, :, 1]), A[1], flip(Bh), flip(Ch), h0[1])
    y = y_f + flip(y_b) + d_skip.astype(f32)[:, None] * xh
    y = y.reshape(bsz, length, M_WIDTH) * jax.nn.silu(z.astype(f32))
    yg = y.reshape(bsz, length, M_GROUPS, M_WIDTH // M_GROUPS)
    yg = yg * lax.rsqrt(jnp.mean(yg * yg, axis=-1, keepdims=True) + EPS)
    out = yg.reshape(bsz, length, M_WIDTH).astype(z.dtype) * norm_w
    return out, (h_f, h_b)


def rwkv_group(proj_r, mu, w0, w2, a0, a2, g2, k_k, k_a, r_k, ln_w, ln_b, s0):
    bsz, length, _ = proj_r.shape
    f32 = jnp.float32
    p = centred_shift(proj_r, mu)
    splits = [R_WIDTH, 2 * R_WIDTH, 3 * R_WIDTH, 3 * R_WIDTH + N_DIR * R_DECAY_LORA,
              3 * R_WIDTH + N_DIR * (R_DECAY_LORA + R_AAA_LORA)]
    r, k, v, xw, xa, xg = jnp.split(p, splits, axis=-1)
    xw = xw.reshape(bsz, length, N_DIR, R_DECAY_LORA)
    xa = xa.reshape(bsz, length, N_DIR, R_AAA_LORA)
    wz = w0 + jnp.einsum('bldr,drc->bldc', jnp.tanh(xw), w2)
    decay = jnp.exp(-R_DECAY_SCALE * jax.nn.sigmoid(wz.astype(f32)))
    a = jax.nn.sigmoid((a0 + jnp.einsum('bldr,drc->bldc', xa, a2)).astype(f32))
    g = jax.nn.sigmoid(xg) @ g2

    def heads(t):
        return t.reshape(*t.shape[:-1], R_HEADS, R_HEADDIM).astype(f32)

    kk = heads(k * k_k)
    kk = kk / jnp.maximum(jnp.sqrt(jnp.sum(kk * kk, axis=-1, keepdims=True)), 1e-12)
    kd = heads(k[:, :, None, :] * (1 + (a - 1) * k_a))
    rh, vh, dh, ah = heads(r), heads(v), heads(decay), heads(a)
    o_f, s_f = wkv7(rh, dh[:, :, 0], kd[:, :, 0], vh, kk, ah[:, :, 0], s0[0])
    o_b, s_b = wkv7(flip(rh), flip(dh[:, :, 1]), flip(kd[:, :, 1]), flip(vh), flip(kk), flip(ah[:, :, 1]), s0[1])
    o = o_f + flip(o_b)
    mean = jnp.mean(o, axis=-1, keepdims=True)
    var = jnp.mean(jnp.square(o - mean), axis=-1, keepdims=True)
    on = ((o - mean) * lax.rsqrt(var + R_LN_EPS)).reshape(bsz, length, R_WIDTH) * ln_w + ln_b
    bonus = jnp.sum(rh[:, :, None] * kd * r_k, axis=(2, 4))[..., None] * vh
    out = (on + bonus.reshape(bsz, length, R_WIDTH)) * g
    return out.astype(proj_r.dtype), (s_f, s_b)


def token_mixer(h, w_in, mamba_p, rwkv_p, init):
    proj = h @ w_in
    z, xbc, dt_raw, pr = jnp.split(proj, [M_WIDTH, M_WIDTH + M_XBC, M_COLS], axis=-1)
    ym, (hf, hb) = mamba_group(z, xbc, dt_raw, *mamba_p, (init[0], init[1]))
    yr, (sf, sb) = rwkv_group(pr, *rwkv_p, (init[2], init[3]))
    return jnp.concatenate([ym, yr.astype(ym.dtype)], axis=-1), (hf, hb, sf, sb)


def zero_states(bsz):
    hm = jnp.zeros((bsz, M_HEADS, M_HEADDIM, M_STATE), jnp.float32)
    sr = jnp.zeros((bsz, R_HEADS, R_HEADDIM, R_HEADDIM), jnp.float32)
    return (hm, hm, sr, sr)


def conv_glu(h, w_up, conv_w, conv_b, w_down, on_grid):
    gate, val = jnp.split(h @ w_up, 2, axis=-1)
    if on_grid:
        gate = dwconv_grid(gate, conv_w, conv_b)
    else:
        gate = dwconv1d(gate, conv_w[FF_CONV // 2], conv_b)
    return (jax.nn.gelu(gate) * val) @ w_down


def setup_inputs(seed: int = 0) -> dict:
    key = jax.random.key(seed)
    ks = iter(jax.random.split(key, 48))

    def nrm(shape, s):
        return jax.random.normal(next(ks), shape, jnp.float32) * s

    def unif(shape, lo, hi):
        return jax.random.uniform(next(ks), shape, jnp.float32, lo, hi)

    dt0 = jnp.exp(unif((DEPTH, N_DIR, M_HEADS), math.log(1e-3), math.log(1e-1)))
    dt_bias = dt0 + jnp.log(-jnp.expm1(-dt0))
    return {
        'x': nrm((BATCH, SEQ, D_MODEL), 1.0),
        'c': nrm((BATCH, D_MODEL), 1.0),
        'ctx': nrm((BATCH, CTX_LEN, D_MODEL), 1.0),
        'c_ctx': nrm((D_MODEL,), 1.0),
        'w_mod': nrm((DEPTH, D_MODEL, N_MOD * D_MODEL), 0.5 * D_MODEL ** -0.5),
        'b_mod': nrm((DEPTH, N_MOD * D_MODEL), 0.02),
        'g_mix_pre': 1.0 + nrm((DEPTH, D_MODEL), 0.02),
        'g_mix_post': 1.0 + nrm((DEPTH, D_MODEL), 0.02),
        'g_ffn_pre': 1.0 + nrm((DEPTH, D_MODEL), 0.02),
        'g_ffn_post': 1.0 + nrm((DEPTH, D_MODEL), 0.02),
        'w_in': nrm((DEPTH, D_MODEL, IN_COLS), D_MODEL ** -0.5),
        'w_out': nrm((DEPTH, D_MIX, D_MODEL), D_MIX ** -0.5),
        'm_conv_w': nrm((DEPTH, M_CONV, M_XBC), M_CONV ** -0.5),
        'm_conv_b': nrm((DEPTH, M_XBC), 0.02),
        'm_dt_bias': dt_bias,
        'm_a_log': jnp.log(unif((DEPTH, N_DIR, M_HEADS), 1.0, 16.0)),
        'm_d': 1.0 + nrm((DEPTH, M_HEADS), 0.02),
        'm_norm_w': 1.0 + nrm((DEPTH, M_WIDTH), 0.02),
        'r_mu': unif((DEPTH, R_COLS), 0.0, 1.0),
        'r_w0': unif((DEPTH, N_DIR, R_WIDTH), -6.0, -0.5),
        'r_w2': nrm((DEPTH, N_DIR, R_DECAY_LORA, R_WIDTH), 0.1 * R_DECAY_LORA ** -0.5),
        'r_a0': nrm((DEPTH, N_DIR, R_WIDTH), 0.1),
        'r_a2': nrm((DEPTH, N_DIR, R_AAA_LORA, R_WIDTH), 0.5 * R_AAA_LORA ** -0.5),
        'r_g2': nrm((DEPTH, R_GATE_LORA, R_WIDTH), R_GATE_LORA ** -0.5),
        'r_k_k': 0.85 + nrm((DEPTH, R_WIDTH), 0.02),
        'r_k_a': 1.0 + nrm((DEPTH, R_WIDTH), 0.02),
        'r_r_k': nrm((DEPTH, R_HEADS, R_HEADDIM), 0.1),
        'r_ln_w': 1.0 + nrm((DEPTH, R_WIDTH), 0.02),
        'r_ln_b': nrm((DEPTH, R_WIDTH), 0.02),
        'f_w_up': nrm((DEPTH, D_MODEL, 2 * D_FF), D_MODEL ** -0.5),
        'f_conv_w': nrm((DEPTH, FF_CONV, FF_CONV, D_FF), 1.0 / FF_CONV),
        'f_conv_b': nrm((DEPTH, D_FF), 0.02),
        'f_w_down': nrm((DEPTH, D_FF, D_MODEL), D_FF ** -0.5),
    }


def reference(x, c, ctx, c_ctx, w_mod, b_mod, g_mix_pre, g_mix_post, g_ffn_pre, g_ffn_post,
              w_in, w_out, m_conv_w, m_conv_b, m_dt_bias, m_a_log, m_d, m_norm_w,
              r_mu, r_w0, r_w2, r_a0, r_a2, r_g2, r_k_k, r_k_a, r_r_k, r_ln_w, r_ln_b,
              f_w_up, f_conv_w, f_conv_b, f_w_down):
    bsz = x.shape[0]
    for l in range(DEPTH):
        mamba_p = (m_conv_w[l], m_conv_b[l], m_dt_bias[l], m_a_log[l], m_d[l], m_norm_w[l])
        rwkv_p = (r_mu[l], r_w0[l], r_w2[l], r_a0[l], r_a2[l], r_g2[l], r_k_k[l], r_k_a[l],
                  r_r_k[l], r_ln_w[l], r_ln_b[l])
        mod_x = (jax.nn.silu(c) @ w_mod[l] + b_mod[l])[:, None, :]
        mod_c = jax.nn.silu(c_ctx) @ w_mod[l] + b_mod[l]
        sx1, cx1, gx1, sx2, cx2, gx2 = jnp.split(mod_x, N_MOD, axis=-1)
        sc1, cc1, gc1, sc2, cc2, gc2 = jnp.split(mod_c, N_MOD, axis=-1)
        hc = modulate(rms_norm(ctx, g_mix_pre[l]), sc1, cc1)
        mc, ctx_states = token_mixer(hc, w_in[l], mamba_p, rwkv_p, zero_states(bsz))
        hx = modulate(rms_norm(x, g_mix_pre[l]), sx1, cx1)
        mx, _ = token_mixer(hx, w_in[l], mamba_p, rwkv_p, ctx_states)
        x = x + gx1 * rms_norm(mx @ w_out[l], g_mix_post[l])
        hx = modulate(rms_norm(x, g_ffn_pre[l]), sx2, cx2)
        x = x + gx2 * rms_norm(conv_glu(hx, f_w_up[l], f_conv_w[l], f_conv_b[l], f_w_down[l], True), g_ffn_post[l])
        if l < DEPTH - 1:
            ctx = ctx + gc1 * rms_norm(mc @ w_out[l], g_mix_post[l])
            hc = modulate(rms_norm(ctx, g_ffn_pre[l]), sc2, cc2)
            ctx = ctx + gc2 * rms_norm(conv_glu(hc, f_w_up[l], f_conv_w[l], f_conv_b[l], f_w_down[l], False), g_ffn_post[l])
    return x
```

```cpp
#include <hip/hip_runtime.h>
#include <hip/hip_cooperative_groups.h>
#include <cstdio>
#include <cstdint>
namespace cg = cooperative_groups;

#define LAS __attribute__((address_space(3)))
typedef unsigned short bf16_t;
typedef short bf16x8 __attribute__((ext_vector_type(8)));
typedef float f32x4 __attribute__((ext_vector_type(4)));
typedef unsigned u32x4 __attribute__((ext_vector_type(4)));
typedef unsigned u32x2 __attribute__((ext_vector_type(2)));
typedef float f32x2 __attribute__((ext_vector_type(2)));

constexpr int DM = 1024, NB = 16, SEQ = 2048, CTX = 256;
constexpr int RC = NB * CTX, RL = NB * SEQ, R = RC + RL;
constexpr int NIN = 3584;
constexpr int PMW = 1536, PRW = 2048;
constexpr int DFF = 2816, NUP = 5632;
constexpr int RCOLS = 1952;
constexpr float EPS = 1e-6f;

constexpr size_t MiB = 1u << 20;
constexpr size_t OFF_MOD = 0, OFF_LORA = 1 * MiB, OFF_WIN = 2 * MiB, OFF_WOUT = 9 * MiB, OFF_WUP = 11 * MiB, OFF_WDN = 22 * MiB;
constexpr size_t OFF_CTX = 28 * MiB, OFF_DT = 44 * MiB, OFF_BIG = 47 * MiB;
constexpr size_t OFF_PR = OFF_BIG, OFF_Y = 191 * MiB, OFF_HN = 263 * MiB, OFF_PM = 335 * MiB;
constexpr size_t OFF_D4 = 263 * MiB, OFF_G = 407 * MiB, OFF_MRAW = 263 * MiB;
constexpr size_t OFF_GV = OFF_BIG, OFF_HN2 = 443 * MiB, WS_NEED = 507 * MiB;
constexpr size_t OFF_BAR = 900 * 1024;
#ifndef WGM_IN
#define WGM_IN 4
#endif
#ifndef WGM_OUT
#define WGM_OUT 4
#endif
#ifndef WGM_UP
#define WGM_UP 4
#endif
#ifndef WGM_DN
#define WGM_DN 4
#endif
constexpr int LDS_BYTES = 131072 + 256;

struct P { const float* in[33]; float* out; unsigned char* ws; };

typedef __bf16 bf16x2_t __attribute__((ext_vector_type(2)));
__device__ __forceinline__ unsigned cvt_pk_bf16(float lo, float hi) { const f32x2 v = {lo, hi}; const bf16x2_t b = __builtin_convertvector(v, bf16x2_t); return __builtin_bit_cast(unsigned, b); }
__device__ __forceinline__ float bflo(unsigned u) { return __uint_as_float(u << 16); }
__device__ __forceinline__ float bfhi(unsigned u) { return __uint_as_float(u & 0xffff0000u); }
__device__ __forceinline__ float bfe(const u32x4& v, int e) { unsigned w = v[e >> 1]; return (e & 1) ? bfhi(w) : bflo(w); }
__device__ __forceinline__ float bfe2(const u32x2& v, int e) { unsigned w = v[e >> 1]; return (e & 1) ? bfhi(w) : bflo(w); }
__device__ __forceinline__ float sigmoidf_(float x) { return __builtin_amdgcn_rcpf(1.f + __expf(-x)); }
__device__ __forceinline__ float siluf_(float x) { return x * __builtin_amdgcn_rcpf(1.f + __expf(-x)); }
__device__ __forceinline__ float tanhf_(float x) { return 1.f - 2.f * __builtin_amdgcn_rcpf(__expf(2.f * x) + 1.f); }
#define LDS_BARRIER() do { asm volatile("s_waitcnt lgkmcnt(0)" ::: "memory"); __builtin_amdgcn_s_barrier(); asm volatile("" ::: "memory"); } while (0)
__device__ __forceinline__ int opq_tid() { int t = threadIdx.x; asm volatile("" : "+v"(t)); return t; }
__device__ __forceinline__ int opq_bid() { int t = blockIdx.x; asm volatile("" : "+s"(t)); return t; }
__device__ __forceinline__ float wave_sum(float v) {
#pragma unroll
    for (int o = 1; o < 64; o <<= 1) v += __shfl_xor(v, o);
    return v;
}
#define DPP_ADD(v, ctrl) ((v) + __int_as_float(__builtin_amdgcn_update_dpp(0, __float_as_int(v), (ctrl), 0xf, 0xf, true)))
__device__ __forceinline__ float red8(float v) { v = DPP_ADD(v, 0xB1); v = DPP_ADD(v, 0x4E); v = DPP_ADD(v, 0x141); return v; }
__device__ __forceinline__ float red16(float v) { v = red8(v); v = DPP_ADD(v, 0x140); return v; }
__device__ __forceinline__ void grid_bar(unsigned* bar, unsigned& epoch, unsigned G) {
    asm volatile("s_waitcnt vmcnt(0)" ::: "memory");
    __syncthreads();
    ++epoch;
    if (threadIdx.x == 0) {
        __threadfence();
        asm volatile("s_waitcnt vmcnt(0)" ::: "memory");
        const unsigned old = __hip_atomic_fetch_add(bar, 1u, __ATOMIC_RELAXED, __HIP_MEMORY_SCOPE_AGENT);
        if (old + 1u == epoch * G) __hip_atomic_store(bar + 64, epoch, __ATOMIC_RELAXED, __HIP_MEMORY_SCOPE_AGENT);
        else while (__hip_atomic_load(bar + 64, __ATOMIC_RELAXED, __HIP_MEMORY_SCOPE_AGENT) < epoch) __builtin_amdgcn_s_sleep(1);
        __threadfence();
        asm volatile("s_waitcnt vmcnt(0)" ::: "memory");
    }
    __syncthreads();
}
#define XB_TMO      128
#define XB_XCNT(j)  (256  + 64 * (j))
#define XB_XSUB(j)  (1280 + 64 * (j))
#define XB_XGEN(j)  (2304 + 64 * (j))
#define XB_TOP      3328
#define XB_TOPGEN   3392
#define XCD_BAR_WORDS 3456
#define XB_SPIN_CAP (1u << 18)
__device__ __forceinline__ unsigned xb_ld(unsigned* p)              { return __hip_atomic_load(p, __ATOMIC_RELAXED, __HIP_MEMORY_SCOPE_AGENT); }
__device__ __forceinline__ unsigned xb_add(unsigned* p, unsigned v) { return __hip_atomic_fetch_add(p, v, __ATOMIC_RELAXED, __HIP_MEMORY_SCOPE_AGENT); }
__device__ __forceinline__ unsigned xb_xcc_id() { return (unsigned)__builtin_amdgcn_s_getreg((3 << 11) | 20) & 0xFu; }
#define XB_SPIN(cond, bar) do { unsigned _sp = 0; while (cond) { __builtin_amdgcn_s_sleep(1); \
    if ((++_sp & 255u) == 0u) { if (xb_ld(&(bar)[XB_TMO])) break; if (_sp > XB_SPIN_CAP) { atomicAdd(&(bar)[XB_TMO], 1u); break; } } } } while (0)
struct XcdBarrier { unsigned* bar; unsigned x; volatile LAS unsigned* st; };
__device__ __forceinline__ XcdBarrier xcd_barrier_post(unsigned* bar, volatile LAS unsigned* st) {
    XcdBarrier b; b.bar = bar; b.x = xb_xcc_id(); b.st = st;
    if (threadIdx.x == 0) (void)xb_add(&bar[XB_XCNT(b.x)], 1u);
    return b;
}
__device__ __forceinline__ void xcd_barrier_complete(unsigned* bar, unsigned x, unsigned& nloc, unsigned& nx) {
    const unsigned G = gridDim.x * gridDim.y * gridDim.z;
    unsigned sum, cnt, mine, sp = 0u;
    for (;;) {
        sum = 0u; cnt = 0u; mine = 0u;
#pragma unroll
        for (unsigned j = 0; j < 16; ++j) { const unsigned c = xb_ld(&bar[XB_XCNT(j)]); sum += c; cnt += (c > 0u) ? 1u : 0u; mine = (j == x) ? c : mine; }
        if (sum == G) break;
        __builtin_amdgcn_s_sleep(1);
        if ((++sp & 255u) == 0u) { if (xb_ld(&bar[XB_TMO])) break; if (sp > XB_SPIN_CAP) { atomicAdd(&bar[XB_TMO], 1u); break; } }
    }
    nloc = mine > 0u ? mine : 1u; nx = cnt > 0u ? cnt : 1u;
}
__device__ __forceinline__ void xcd_barrier(unsigned* bar_, volatile LAS unsigned* st_) {
    XcdBarrier b; b.bar = bar_; b.st = st_; b.x = 0u;
    asm volatile("s_waitcnt vmcnt(0)" ::: "memory");
    __syncthreads();
    if (threadIdx.x == 0) {
        unsigned* bar = b.bar; b.x = xb_xcc_id();
        __builtin_amdgcn_s_waitcnt(0);
        unsigned nloc = b.st[0], nx = b.st[1];
        if (nloc == 0u) { xcd_barrier_complete(bar, b.x, nloc, nx); b.st[0] = nloc; b.st[1] = nx; }
        const unsigned old = xb_add(&bar[XB_XSUB(b.x)], 1u);
        const unsigned gen = old / nloc;
        if (old + 1u == (gen + 1u) * nloc) {
            __builtin_amdgcn_fence(__ATOMIC_RELEASE, "agent");
            asm volatile("s_waitcnt vmcnt(0)" ::: "memory");
            const unsigned og = xb_add(&bar[XB_TOP], 1u);
            const unsigned tg = og / nx;
            if (og + 1u == (tg + 1u) * nx) xb_add(&bar[XB_TOPGEN], 1u);
            else XB_SPIN(xb_ld(&bar[XB_TOPGEN]) == tg, bar);
            __builtin_amdgcn_fence(__ATOMIC_ACQUIRE, "agent");
            xb_add(&bar[XB_XGEN(b.x)], 1u);
            asm volatile("s_waitcnt vmcnt(0)" ::: "memory");
        } else {
            XB_SPIN(xb_ld(&bar[XB_XGEN(b.x)]) == gen, bar);
            __builtin_amdgcn_fence(__ATOMIC_ACQUIRE, "agent");
            asm volatile("s_waitcnt vmcnt(0)" ::: "memory");
        }
    }
    __syncthreads();
}
__device__ __forceinline__ void row_info(int row, int& first, int& last, int& mrow) {
    if (row < RC) { int t = row & (CTX - 1); first = (t == 0); last = (t == CTX - 1); mrow = 16; }
    else { int rr = row - RC; int t = rr & (SEQ - 1); first = (t == 0); last = (t == SEQ - 1); mrow = rr >> 11; }
}
__device__ __forceinline__ void seqpos(int s, int dir, int b, int& row, int& first, int& last) {
    if (s < CTX) { int t = dir ? (CTX - 1 - s) : s; row = b * CTX + t; first = (t == 0); last = (t == CTX - 1); }
    else { int u = s - CTX; int t = dir ? (SEQ - 1 - u) : u; row = RC + b * SEQ + t; first = (t == 0); last = (t == SEQ - 1); }
}

namespace pg8 {
constexpr int BM = 256, BK = 64, HALF = 128, HTB = HALF * BK * 2, NXCD = 8;
__device__ __forceinline__ int lds_byte(int r, int c) { const int st = (r >> 4) * 2 + (c >> 5), rr = r & 15, cc = c & 31, ob = rr * 64 + cc * 2; return st * 1024 + (ob ^ (((ob >> 9) & 1) << 5)); }
__device__ __forceinline__ void stage_rc(int b, int& Rr, int& C) { const int st = b / 1024, sb = b % 1024, swz = sb ^ (((sb >> 9) & 1) << 5); Rr = (st >> 1) * 16 + swz / 64; C = (st & 1) * 32 + (swz % 64) / 2; }
__device__ __forceinline__ int perm32(int rho) { const int n = rho >> 4, i = rho & 15; return 8 * (i >> 2) + 4 * n + (i & 3); }
struct Unit { int pm, pn; };
struct Gemm { const bf16_t* A; const bf16_t* Bt; int M, N, K, lda; };
struct StaticOrder {
    int nM, nN, nwg, G, c, WGM;
    __device__ void init(int M, int N, int G_, int c_, int wgm_) { nM = M / BM; nN = N / BM; nwg = nM * nN; G = G_; c = c_; WGM = wgm_; }
    __device__ bool next(int i, Unit& u) const {
        const long L = (long)i * G + c; if (L >= nwg) return false;
        int wgid = (int)L; { const int q = nwg / NXCD, r = nwg % NXCD, xcd = wgid % NXCD, off = wgid / NXCD; wgid = (xcd < r ? xcd * (q + 1) : r * (q + 1) + (xcd - r) * q) + off; }
        const int nig = WGM * nN, gid = wgid / nig, fm = gid * WGM, gsz = (nM - fm) < WGM ? (nM - fm) : WGM;
        u.pm = fm + ((wgid % nig) % gsz); u.pn = (wgid % nig) / gsz; return true;
    }
};
struct EpiStore {
    bf16_t* O; int ldc;
    __device__ __forceinline__ void operator()(const f32x4 (&acc)[2][2][4][2], const Unit& u, int wr, int wc, int fr, int fq) const {
        const int row0 = u.pm * BM + wr * 64 + fr, col0 = u.pn * BM + wc * 32 + 8 * fq;
#pragma unroll
        for (int ai = 0; ai < 2; ++ai)
#pragma unroll
            for (int m = 0; m < 4; ++m) { bf16_t* rowp = O + (size_t)(row0 + ai * HALF + m * 16) * ldc + col0;
#pragma unroll
                for (int bj = 0; bj < 2; ++bj) { const f32x4 v0 = acc[ai][bj][m][0], v1 = acc[ai][bj][m][1];
                    u32x4 w; w.x = cvt_pk_bf16(v0[0], v0[1]); w.y = cvt_pk_bf16(v0[2], v0[3]); w.z = cvt_pk_bf16(v1[0], v1[1]); w.w = cvt_pk_bf16(v1[2], v1[3]);
                    *(u32x4*)(rowp + bj * HALF) = w; } }
    }
};
struct EpiInProj {
    bf16_t* PM; bf16_t* PR; float* DT;
    __device__ __forceinline__ void operator()(const f32x4 (&acc)[2][2][4][2], const Unit& u, int wr, int wc, int fr, int fq) const {
        const int row0 = u.pm * BM + wr * 64 + fr;
        bf16_t* base; int ldc, colt;
        if (u.pn < 6) { base = PM; ldc = PMW; colt = u.pn * BM; } else { base = PR; ldc = PRW; colt = (u.pn - 6) * BM; }
        const int col0 = colt + wc * 32 + 8 * fq;
        const bool isdt = (u.pn == 13) && (wc == 1) && (fq < 2);
#pragma unroll
        for (int ai = 0; ai < 2; ++ai)
#pragma unroll
            for (int m = 0; m < 4; ++m) { const int row = row0 + ai * HALF + m * 16; bf16_t* rowp = base + (size_t)row * ldc + col0;
#pragma unroll
                for (int bj = 0; bj < 2; ++bj) { const f32x4 v0 = acc[ai][bj][m][0], v1 = acc[ai][bj][m][1];
                    u32x4 w; w.x = cvt_pk_bf16(v0[0], v0[1]); w.y = cvt_pk_bf16(v0[2], v0[3]); w.z = cvt_pk_bf16(v1[0], v1[1]); w.w = cvt_pk_bf16(v1[2], v1[3]);
                    *(u32x4*)(rowp + bj * HALF) = w; }
                if (isdt) { float* d = DT + (size_t)row * 16 + fq * 8; *(f32x4*)d = acc[ai][1][m][0]; *(f32x4*)(d + 4) = acc[ai][1][m][1]; } }
    }
};

template <class Epi>
__device__ __forceinline__ void gemm_phase(LAS unsigned char* lds, const Gemm g, const StaticOrder& S, const Epi& E) {
    const int tid = opq_tid(), wid = __builtin_amdgcn_readfirstlane(tid >> 6), lane = tid & 63, wr = wid >> 2, wc = wid & 3, fr = lane & 15, fq = lane >> 4;
    const int K = g.K, nt = K / BK, lda = g.lda;
    unsigned voffA[2], voffB[2];
#pragma unroll
    for (int i = 0; i < 2; ++i) { int Rr, C; stage_rc(tid * 16 + i * 8192, Rr, C); const int Rb = (Rr & ~31) + perm32(Rr & 31);
        voffA[i] = (unsigned)(Rr * lda + C) * 2u; voffB[i] = (unsigned)(Rb * K + C) * 2u; }
    const size_t kstep = (size_t)(BK * 2);
    const size_t hsA = (size_t)HALF * lda * 2, hsB = (size_t)HALF * K * 2;
    const size_t tsA = 2 * hsA, tsB = 2 * hsB;
    const unsigned ldsw = (unsigned)wid * 1024u;
    const int aoff = lds_byte(wr * 64 + fr, fq * 8), boff = lds_byte(wc * 32 + fr, fq * 8);
#define PG8_SA(b, h) (((b) * 2 + (h)) * HTB)
#define PG8_SB(b, h) ((4 + (b) * 2 + (h)) * HTB)
#define PG8_STAGE(bufoff, gbase, voff) do { _Pragma("unroll") for (int _i = 0; _i < 2; ++_i) \
        __builtin_amdgcn_global_load_lds((const unsigned*)((const char*)(gbase) + (voff)[_i]), (LAS unsigned*)(lds + (bufoff) + ldsw + _i * 8192), 16, 0, 0); } while (0)
#define PG8_LDA(dst, b, h) do { _Pragma("unroll") for (int m = 0; m < 4; ++m) _Pragma("unroll") for (int k = 0; k < 2; ++k) dst[m][k] = *(const LAS bf16x8*)(lds + PG8_SA(b, h) + aoff + m * 2048 + k * 1024); } while (0)
#define PG8_LDB(dst, b, h) do { _Pragma("unroll") for (int n = 0; n < 2; ++n) _Pragma("unroll") for (int k = 0; k < 2; ++k) dst[n][k] = *(const LAS bf16x8*)(lds + PG8_SB(b, h) + boff + n * 2048 + k * 1024); } while (0)
#define PG8_MMA(ai, bj, At, Bt) do { __builtin_amdgcn_s_setprio(1); _Pragma("unroll") for (int m = 0; m < 4; ++m) _Pragma("unroll") for (int n = 0; n < 2; ++n) _Pragma("unroll") for (int k = 0; k < 2; ++k) \
        acc[ai][bj][m][n] = __builtin_amdgcn_mfma_f32_16x16x32_bf16(Bt[n][k], At[m][k], acc[ai][bj][m][n], 0, 0, 0); __builtin_amdgcn_s_setprio(0); } while (0)
#define PG8_WAIT_V(n) asm volatile("s_waitcnt vmcnt(" #n ")" ::: "memory")
#define PG8_WAIT_L(n) asm volatile("s_waitcnt lgkmcnt(" #n ")" ::: "memory")
#define PG8_BAR __builtin_amdgcn_s_barrier()
#define PG8_SCHED __builtin_amdgcn_sched_barrier(0)
    Unit cur, nxt; int ui = 0;
    if (!S.next(0, cur)) return;
    f32x4 acc[2][2][4][2];
#pragma unroll
    for (int a = 0; a < 2; ++a)
#pragma unroll
        for (int b = 0; b < 2; ++b)
#pragma unroll
            for (int m = 0; m < 4; ++m)
#pragma unroll
                for (int n = 0; n < 2; ++n) acc[a][b][m][n] = (f32x4){0.f, 0.f, 0.f, 0.f};
    bf16x8 At[4][2], B0[2][2], B1[2][2];
    const char* cA = (const char*)g.A + (size_t)cur.pm * tsA; const char* cB = (const char*)g.Bt + (size_t)cur.pn * tsB;
    PG8_STAGE(PG8_SB(0, 0), cB, voffB); PG8_STAGE(PG8_SB(0, 1), cB + hsB, voffB); PG8_STAGE(PG8_SA(0, 0), cA, voffA); PG8_STAGE(PG8_SA(0, 1), cA + hsA, voffA);
    if (wr == 1) PG8_BAR;
    PG8_WAIT_V(2); PG8_BAR;
    PG8_STAGE(PG8_SB(1, 0), cB + kstep, voffB); PG8_STAGE(PG8_SA(1, 0), cA + kstep, voffA); PG8_STAGE(PG8_SB(1, 1), cB + hsB + kstep, voffB);
    PG8_WAIT_V(6); PG8_BAR;
    for (;;) {
        const bool has_next = S.next(ui + 1, nxt);
        const char* nA = has_next ? (const char*)g.A + (size_t)nxt.pm * tsA : cA; const char* nB = has_next ? (const char*)g.Bt + (size_t)nxt.pn * tsB : cB;
        for (int t = 0; t < nt; t += 2) {
            const bool last = (t == nt - 2);
            const char* a1 = cA + (size_t)(t + 1) * kstep;
            const char* a2 = last ? nA : cA + (size_t)(t + 2) * kstep; const char* b2 = last ? nB : cB + (size_t)(t + 2) * kstep;
            const char* a3 = a2 + kstep; const char* b3 = b2 + kstep;
            PG8_LDB(B0, 0, 0); PG8_LDB(B1, 0, 1); PG8_SCHED; PG8_LDA(At, 0, 0); PG8_STAGE(PG8_SA(1, 1), a1 + hsA, voffA);
            PG8_WAIT_V(8); PG8_WAIT_L(0); PG8_BAR; PG8_MMA(0, 0, At, B0); PG8_MMA(0, 1, At, B1); PG8_BAR; PG8_SCHED;
            PG8_LDA(At, 0, 1); PG8_STAGE(PG8_SB(0, 0), b2, voffB); PG8_STAGE(PG8_SB(0, 1), b2 + hsB, voffB); PG8_STAGE(PG8_SA(0, 0), a2, voffA);
            PG8_WAIT_V(8); PG8_WAIT_L(0); PG8_BAR; PG8_MMA(1, 0, At, B0); PG8_MMA(1, 1, At, B1); PG8_BAR; PG8_SCHED;
            PG8_LDB(B0, 1, 0); PG8_LDB(B1, 1, 1); PG8_SCHED; PG8_LDA(At, 1, 0); PG8_STAGE(PG8_SA(0, 1), a2 + hsA, voffA);
            PG8_WAIT_V(8); PG8_WAIT_L(0); PG8_BAR; PG8_MMA(0, 0, At, B0); PG8_MMA(0, 1, At, B1); PG8_BAR; PG8_SCHED;
            PG8_LDA(At, 1, 1); PG8_STAGE(PG8_SB(1, 0), b3, voffB); PG8_STAGE(PG8_SB(1, 1), b3 + hsB, voffB); PG8_STAGE(PG8_SA(1, 0), a3, voffA);
            PG8_WAIT_V(8); PG8_WAIT_L(0); PG8_BAR; PG8_MMA(1, 0, At, B0); PG8_MMA(1, 1, At, B1); PG8_BAR; PG8_SCHED;
        }
        if (wr == 0) PG8_BAR;
        E(acc, cur, wr, wc, fr, fq);
        if (!has_next) break;
#pragma unroll
        for (int a = 0; a < 2; ++a)
#pragma unroll
            for (int b = 0; b < 2; ++b)
#pragma unroll
                for (int m = 0; m < 4; ++m)
#pragma unroll
                    for (int n = 0; n < 2; ++n) acc[a][b][m][n] = (f32x4){0.f, 0.f, 0.f, 0.f};
        cur = nxt; cA = nA; cB = nB; ++ui;
        if (wr == 1) PG8_BAR;
    }
    PG8_WAIT_V(0);
    PG8_BAR;
#undef PG8_SA
#undef PG8_SB
#undef PG8_STAGE
#undef PG8_LDA
#undef PG8_LDB
#undef PG8_MMA
#undef PG8_WAIT_V
#undef PG8_WAIT_L
#undef PG8_BAR
#undef PG8_SCHED
}
}

__device__ __forceinline__ int win_colmap(int j) { return j < 1536 ? j : (j < 3488 ? j + 16 : (j < 3504 ? j - 1952 : -1)); }
template <bool WIN>
__device__ __forceinline__ void transpose_tile(LAS float* tile, const float* W, int K, int N, bf16_t* WT, int item, int ntn) {
    const int tid = opq_tid(), n0 = (item % ntn) * 64, k0 = (item / ntn) * 64;
    const int tx = tid & 63, ty = tid >> 6;
    int col = n0 + tx; if (WIN) col = win_colmap(col);
#pragma unroll
    for (int i = 0; i < 8; ++i) { const int kk = ty + i * 8; tile[kk * 65 + tx] = (col >= 0) ? W[(size_t)(k0 + kk) * N + col] : 0.f; }
    __syncthreads();
    const int n = tid >> 3, ks = (tid & 7) * 8;
    u32x4 o; o.x = cvt_pk_bf16(tile[(ks + 0) * 65 + n], tile[(ks + 1) * 65 + n]); o.y = cvt_pk_bf16(tile[(ks + 2) * 65 + n], tile[(ks + 3) * 65 + n]);
    o.z = cvt_pk_bf16(tile[(ks + 4) * 65 + n], tile[(ks + 5) * 65 + n]); o.w = cvt_pk_bf16(tile[(ks + 6) * 65 + n], tile[(ks + 7) * 65 + n]);
    *(u32x4*)(WT + (size_t)(n0 + n) * K + k0 + ks) = o;
    __syncthreads();
}
__device__ __forceinline__ void convert_weights(LAS unsigned char* lds, const P& p, int l) {
    LAS float* tile = (LAS float*)lds;
    unsigned char* ws = p.ws;
    constexpr int I_IN = (NIN / 64) * (DM / 64), I_OUT = 16 * 16, I_UP = (NUP / 64) * 16, I_DN = 16 * (DFF / 64);
    for (int it = opq_bid(); it < I_IN + I_OUT + I_UP + I_DN; it += gridDim.x) {
        int r = it;
        if (r < I_IN) { transpose_tile<true>(tile, p.in[10] + (size_t)l * DM * 3504, DM, 3504, (bf16_t*)(ws + OFF_WIN), r, NIN / 64); continue; } r -= I_IN;
        if (r < I_OUT) { transpose_tile<false>(tile, p.in[11] + (size_t)l * DM * DM, DM, DM, (bf16_t*)(ws + OFF_WOUT), r, 16); continue; } r -= I_OUT;
        if (r < I_UP) { transpose_tile<false>(tile, p.in[29] + (size_t)l * DM * NUP, DM, NUP, (bf16_t*)(ws + OFF_WUP), r, NUP / 64); continue; } r -= I_UP;
        transpose_tile<false>(tile, p.in[32] + (size_t)l * DFF * DM, DFF, DM, (bf16_t*)(ws + OFF_WDN), r, 16);
    }
    bf16_t* W2t = (bf16_t*)(ws + OFF_LORA); bf16_t* A2t = W2t + 2 * 512 * 64; bf16_t* G2t = A2t + 2 * 512 * 64;
    const int gt = opq_bid() * 512 + opq_tid(), gs = gridDim.x * 512;
    for (int i = gt; i < 2 * 512 * 64; i += gs) { const int d = i >> 15, n = (i >> 6) & 511, k = i & 63;
        W2t[i] = (bf16_t)(cvt_pk_bf16(p.in[20][((size_t)(l * 2 + d) * 64 + k) * 512 + n], 0.f) & 0xffffu);
        A2t[i] = (bf16_t)(cvt_pk_bf16(p.in[22][((size_t)(l * 2 + d) * 64 + k) * 512 + n], 0.f) & 0xffffu); }
    for (int i = gt; i < 512 * 160; i += gs) { const int n = i / 160, k = i % 160;
        G2t[i] = (bf16_t)(cvt_pk_bf16(p.in[23][((size_t)l * 160 + k) * 512 + n], 0.f) & 0xffffu); }
}

__device__ __forceinline__ void mod_phase(LAS unsigned char* lds, const P& p) {
    LAS float* sil = (LAS float*)lds;
    LAS float* red = sil + 17 * 1024;
    const int tid = opq_tid();
    float* mod = (float*)(p.ws + OFF_MOD);
    if ((int)opq_bid() >= 384) return;
    __syncthreads();
    for (int i = tid; i < 17 * 1024; i += 512) { const int r = i >> 10, k = i & 1023; const float v = (r < 16) ? p.in[1][r * 1024 + k] : p.in[3][k]; sil[i] = siluf_(v); }
    __syncthreads();
    for (int item = opq_bid(); item < 384; item += gridDim.x) {
        const int l = item / 192, cb = item % 192, cc = tid & 31, kg = tid >> 5, col = cb * 32 + cc;
        float acc[17];
#pragma unroll
        for (int r = 0; r < 17; ++r) acc[r] = 0.f;
        const float* wp = p.in[4] + ((size_t)l * 1024 + kg * 64) * 6144 + col;
#pragma unroll 4
        for (int kk = 0; kk < 64; ++kk) { const float w = wp[(size_t)kk * 6144]; const int k = kg * 64 + kk;
#pragma unroll
            for (int r = 0; r < 17; ++r) acc[r] += sil[r * 1024 + k] * w; }
#pragma unroll
        for (int r = 0; r < 17; ++r) red[(kg * 17 + r) * 32 + cc] = acc[r];
        __syncthreads();
        for (int idx = tid; idx < 17 * 32; idx += 512) { const int r = idx >> 5, c2 = idx & 31; float s = p.in[5][l * 6144 + cb * 32 + c2];
            for (int k2 = 0; k2 < 16; ++k2) s += red[(k2 * 17 + r) * 32 + c2];
            mod[(size_t)(l * 17 + r) * 6144 + cb * 32 + c2] = s; }
        __syncthreads();
    }
}

template <bool POST, bool NORM>
__device__ __forceinline__ void row_phase(const P& p, int l, int lN, int r0, int r1,
                                          const float* xlat, const float* xctx,
                                          const bf16_t* M, int ldm, int mbase,
                                          const float* gpost, int gateoff,
                                          float* olat, float* octx,
                                          const float* gpre, int shoff,
                                          bf16_t* HN, int hbase) {
    const int lane = opq_tid() & 63, wid = opq_tid() >> 6;
    const float* mod = (const float*)(p.ws + OFF_MOD);
    const int npair = (r1 - r0) >> 1, pend = npair, pstep = (int)gridDim.x * 8;
    f32x4 gt[4], sh[4], sc[4];
    int curm = -1;
    f32x4 xA[2][4], xB[2][4]; u32x2 mA[2][4], mB[2][4];
#define RP_LOAD(X, pr_) do { const int rowb_ = r0 + (pr_) * 2; const bool isc_ = rowb_ < RC; \
        const float* xr_ = isc_ ? xctx + (size_t)rowb_ * DM : xlat + (size_t)(rowb_ - RC) * DM; \
        _Pragma("unroll") for (int u = 0; u < 2; ++u) _Pragma("unroll") for (int i = 0; i < 4; ++i) x##X[u][i] = *(const f32x4*)(xr_ + u * DM + i * 256 + lane * 4); \
        if (POST) { const bf16_t* mr_ = M + (size_t)(rowb_ - mbase) * ldm; \
            _Pragma("unroll") for (int u = 0; u < 2; ++u) _Pragma("unroll") for (int i = 0; i < 4; ++i) m##X[u][i] = *(const u32x2*)(mr_ + (size_t)u * ldm + i * 256 + lane * 4); } } while (0)
#define RP_COMPUTE(X, pr_) do { const int rowb = r0 + (pr_) * 2; const bool isc = rowb < RC; const int mrow = isc ? 16 : ((rowb - RC) >> 11); \
        if (mrow != curm) { curm = mrow; \
            _Pragma("unroll") for (int i = 0; i < 4; ++i) { const int c = i * 256 + lane * 4; \
                if (POST) gt[i] = *(const f32x4*)(mod + (size_t)(l * 17 + mrow) * 6144 + gateoff + c); \
                if (NORM) { sh[i] = *(const f32x4*)(mod + (size_t)(lN * 17 + mrow) * 6144 + shoff + c); sc[i] = *(const f32x4*)(mod + (size_t)(lN * 17 + mrow) * 6144 + shoff + 1024 + c); } } } \
        if (POST) { float ss0 = 0.f, ss1 = 0.f; f32x4 mv[2][4]; \
            _Pragma("unroll") for (int i = 0; i < 4; ++i) { \
                const u32x2 w0 = m##X[0][i], w1 = m##X[1][i]; \
                mv[0][i] = (f32x4){bflo(w0.x), bfhi(w0.x), bflo(w0.y), bfhi(w0.y)}; mv[1][i] = (f32x4){bflo(w1.x), bfhi(w1.x), bflo(w1.y), bfhi(w1.y)}; \
                ss0 += mv[0][i][0] * mv[0][i][0] + mv[0][i][1] * mv[0][i][1] + mv[0][i][2] * mv[0][i][2] + mv[0][i][3] * mv[0][i][3]; \
                ss1 += mv[1][i][0] * mv[1][i][0] + mv[1][i][1] * mv[1][i][1] + mv[1][i][2] * mv[1][i][2] + mv[1][i][3] * mv[1][i][3]; } \
            const float rs0 = rsqrtf(wave_sum(ss0) * (1.f / DM) + EPS), rs1 = rsqrtf(wave_sum(ss1) * (1.f / DM) + EPS); \
            float* orow = isc ? octx + (size_t)rowb * DM : olat + (size_t)(rowb - RC) * DM; \
            _Pragma("unroll") for (int i = 0; i < 4; ++i) { const int c = i * 256 + lane * 4; \
                const f32x4 gpi = *(const f32x4*)(gpost + c); \
                x##X[0][i] = x##X[0][i] + gt[i] * (mv[0][i] * rs0 * gpi); x##X[1][i] = x##X[1][i] + gt[i] * (mv[1][i] * rs1 * gpi); \
                *(f32x4*)(orow + c) = x##X[0][i]; *(f32x4*)(orow + DM + c) = x##X[1][i]; } } \
        if (NORM) { float ss0 = 0.f, ss1 = 0.f; \
            _Pragma("unroll") for (int i = 0; i < 4; ++i) { \
                ss0 += x##X[0][i][0] * x##X[0][i][0] + x##X[0][i][1] * x##X[0][i][1] + x##X[0][i][2] * x##X[0][i][2] + x##X[0][i][3] * x##X[0][i][3]; \
                ss1 += x##X[1][i][0] * x##X[1][i][0] + x##X[1][i][1] * x##X[1][i][1] + x##X[1][i][2] * x##X[1][i][2] + x##X[1][i][3] * x##X[1][i][3]; } \
            const float rs0 = rsqrtf(wave_sum(ss0) * (1.f / DM) + EPS), rs1 = rsqrtf(wave_sum(ss1) * (1.f / DM) + EPS); \
            bf16_t* hr = HN + (size_t)(rowb - hbase) * DM; \
            _Pragma("unroll") for (int i = 0; i < 4; ++i) { const int c = i * 256 + lane * 4; \
                const f32x4 g4i = *(const f32x4*)(gpre + c); \
                const f32x4 y0 = (x##X[0][i] * rs0 * g4i) * (sc[i] + 1.f) + sh[i], y1 = (x##X[1][i] * rs1 * g4i) * (sc[i] + 1.f) + sh[i]; \
                u32x2 o; o.x = cvt_pk_bf16(y0[0], y0[1]); o.y = cvt_pk_bf16(y0[2], y0[3]); *(u32x2*)(hr + c) = o; \
                o.x = cvt_pk_bf16(y1[0], y1[1]); o.y = cvt_pk_bf16(y1[2], y1[3]); *(u32x2*)(hr + DM + c) = o; } } } while (0)
    int pr = opq_bid() * 8 + wid;
    if (pr < pend) RP_LOAD(A, pr);
    while (pr < pend) {
        int pn = pr + pstep;
        if (pn < pend) RP_LOAD(B, pn);
        __builtin_amdgcn_sched_barrier(0);
        RP_COMPUTE(A, pr);
        __builtin_amdgcn_sched_barrier(0);
        pr = pn; if (pr >= pend) break;
        pn = pr + pstep;
        if (pn < pend) RP_LOAD(A, pn);
        __builtin_amdgcn_sched_barrier(0);
        RP_COMPUTE(B, pr);
        __builtin_amdgcn_sched_barrier(0);
        pr = pn;
    }
#undef RP_LOAD
#undef RP_COMPUTE
}

__device__ __forceinline__ void xbc_phase(const P& p, int l) {
    const bf16_t* PM = (const bf16_t*)(p.ws + OFF_PM);
    bf16_t* XBC = (bf16_t*)(p.ws + OFF_HN);
    const float* cw = p.in[12] + (size_t)l * 3 * 1024; const float* cb = p.in[13] + (size_t)l * 1024;
    const int idx0 = opq_bid() * 512 + opq_tid(), istep = (int)gridDim.x * 512, c8 = (idx0 & 127) * 8;
    f32x4 w0[2], w1[2], w2[2], bb[2];
#pragma unroll
    for (int hh = 0; hh < 2; ++hh) { w0[hh] = *(const f32x4*)(cw + c8 + hh * 4); w1[hh] = *(const f32x4*)(cw + 1024 + c8 + hh * 4); w2[hh] = *(const f32x4*)(cw + 2048 + c8 + hh * 4); bb[hh] = *(const f32x4*)(cb + c8 + hh * 4); }
    const u32x4 z4 = (u32x4){0u, 0u, 0u, 0u};
    u32x4 xcA, xpA, xnA, xcB, xpB, xnB; int flA = 0, flB = 0;
#define XQ_LOAD(X, idx_) do { const int row_ = (idx_) >> 7; int f_, l_, m_; row_info(row_, f_, l_, m_); const bf16_t* src = PM + (size_t)row_ * PMW + 512 + c8; \
        xc##X = *(const u32x4*)src; xp##X = *(const u32x4*)(src - (f_ ? 0 : PMW)); xn##X = *(const u32x4*)(src + (l_ ? 0 : PMW)); fl##X = f_ | (l_ << 1); } while (0)
#define XQ_COMPUTE(X, idx_) do { float o[8]; const u32x4 xp_ = (fl##X & 1) ? z4 : xp##X, xn_ = (fl##X & 2) ? z4 : xn##X; \
        _Pragma("unroll") for (int hh = 0; hh < 2; ++hh) _Pragma("unroll") for (int e = 0; e < 4; ++e) \
            o[hh * 4 + e] = siluf_(w0[hh][e] * bfe(xp_, hh * 4 + e) + w1[hh][e] * bfe(xc##X, hh * 4 + e) + w2[hh][e] * bfe(xn_, hh * 4 + e) + bb[hh][e]); \
        u32x4 w; w.x = cvt_pk_bf16(o[0], o[1]); w.y = cvt_pk_bf16(o[2], o[3]); w.z = cvt_pk_bf16(o[4], o[5]); w.w = cvt_pk_bf16(o[6], o[7]); \
        *(u32x4*)(XBC + (size_t)((idx_) >> 7) * 1024 + c8) = w; } while (0)
    const int iend = R * 128;
    int idx = idx0;
    if ((istep & 127) != 0) {
        for (; idx < iend; idx += istep) { const int row = idx >> 7, cc = (idx & 127) * 8; int first, last, mrow; row_info(row, first, last, mrow);
            const bf16_t* src = PM + (size_t)row * PMW + 512 + cc;
            const u32x4 xc = *(const u32x4*)src, xp = first ? z4 : *(const u32x4*)(src - PMW), xn = last ? z4 : *(const u32x4*)(src + PMW);
            float o[8];
#pragma unroll
            for (int e = 0; e < 8; ++e) o[e] = siluf_(cw[cc + e] * bfe(xp, e) + cw[1024 + cc + e] * bfe(xc, e) + cw[2048 + cc + e] * bfe(xn, e) + cb[cc + e]);
            u32x4 w; w.x = cvt_pk_bf16(o[0], o[1]); w.y = cvt_pk_bf16(o[2], o[3]); w.z = cvt_pk_bf16(o[4], o[5]); w.w = cvt_pk_bf16(o[6], o[7]);
            *(u32x4*)(XBC + (size_t)row * 1024 + cc) = w; }
        return;
    }
    if (idx < iend) XQ_LOAD(A, idx);
    while (idx < iend) {
        int in_ = idx + istep;
        if (in_ < iend) XQ_LOAD(B, in_);
        __builtin_amdgcn_sched_barrier(0);
        XQ_COMPUTE(A, idx);
        __builtin_amdgcn_sched_barrier(0);
        idx = in_; if (idx >= iend) break;
        in_ = idx + istep;
        if (in_ < iend) XQ_LOAD(A, in_);
        __builtin_amdgcn_sched_barrier(0);
        XQ_COMPUTE(B, idx);
        __builtin_amdgcn_sched_barrier(0);
        idx = in_;
    }
#undef XQ_LOAD
#undef XQ_COMPUTE
}

__device__ __forceinline__ void mamba_chunk_phase(LAS unsigned char* lds, const P& p, int l) {
    constexpr int Q = 64, NCH = (CTX + SEQ) / Q, SX = 72, SB = 136;
    LAS bf16_t* XT = (LAS bf16_t*)lds;
    LAS bf16_t* XsT = XT + 64 * SX;
    LAS bf16_t* Mm = XsT + 64 * SX;
    LAS bf16_t* BT = Mm + 64 * SX;
    LAS bf16_t* Bm = BT + 128 * SX;
    LAS bf16_t* Cm = Bm + 64 * SB;
    LAS bf16_t* Hb = Cm + 64 * SB;
    LAS float* fab = (LAS float*)(Hb + 64 * SB);
    const int tid = opq_tid(), lane = tid & 63, w = tid >> 6, fr = lane & 15, fq = lane >> 4;
    const bf16_t* XBC = (const bf16_t*)(p.ws + OFF_HN);
    const float* DT = (const float*)(p.ws + OFF_DT);
    bf16_t* Y = (bf16_t*)(p.ws + OFF_Y);
    for (int q = opq_bid(); q < 256; q += gridDim.x) {
        const int b = q >> 4, h = (q >> 1) & 7, dir = q & 1, g = h >> 2;
        const float dtb = p.in[14][l * 16 + dir * 8 + h];
        const float Aneg = -expf(p.in[15][l * 16 + dir * 8 + h]);
        f32x4 Hacc[4];
#pragma unroll
        for (int i = 0; i < 4; ++i) Hacc[i] = (f32x4){0.f, 0.f, 0.f, 0.f};
        u32x4 pre[5]; float dtraw = 0.f;
#define C_ISSUE(ci) do { int row, first, last; seqpos((ci) * Q + lane, dir, b, row, first, last); const bf16_t* rp = XBC + (size_t)row * 1024; \
            _Pragma("unroll") for (int i = 0; i < 5; ++i) { const int pc = w + 8 * i; \
                const int col = pc < 8 ? h * 64 + pc * 8 : (pc < 24 ? 512 + g * 128 + (pc - 8) * 8 : 768 + g * 128 + (pc - 24) * 8); \
                pre[i] = *(const u32x4*)(rp + col); } \
            if (tid < Q) dtraw = DT[(size_t)row * 16 + dir * 8 + h]; } while (0)
#define C_STORE() do { const int j = lane; _Pragma("unroll") for (int i = 0; i < 5; ++i) { const int pc = w + 8 * i; const u32x4 v = pre[i]; \
            if (pc < 8) { _Pragma("unroll") for (int e = 0; e < 8; ++e) XT[(pc * 8 + e) * SX + j] = (bf16_t)((e & 1) ? (v[e >> 1] >> 16) : (v[e >> 1] & 0xffffu)); } \
            else if (pc < 24) { const int n0 = (pc - 8) * 8; *(LAS u32x4*)(Bm + j * SB + n0) = v; \
                _Pragma("unroll") for (int e = 0; e < 8; ++e) BT[(n0 + e) * SX + j] = (bf16_t)((e & 1) ? (v[e >> 1] >> 16) : (v[e >> 1] & 0xffffu)); } \
            else { const int n0 = (pc - 24) * 8; *(LAS u32x4*)(Cm + j * SB + n0) = v; } } } while (0)
        __syncthreads();
        for (int i = tid; i < 64 * SB / 2; i += 512) ((LAS unsigned*)Hb)[i] = 0u;
        C_ISSUE(0); C_STORE();
        float dtcur = dtraw;
        if (w == 0) { LAS float* faw = fab;
                const float xx = dtcur + dtb; const float dt = xx > 20.f ? xx : log1pf(__expf(xx));
                float a = dt * Aneg;
                a = DPP_ADD(a, 0x111); a = DPP_ADD(a, 0x112); a = DPP_ADD(a, 0x114); a = DPP_ADD(a, 0x118);
                const float t15 = __int_as_float(__builtin_amdgcn_readlane(__float_as_int(a), 15));
                const float t31 = __int_as_float(__builtin_amdgcn_readlane(__float_as_int(a), 31));
                const float t47 = __int_as_float(__builtin_amdgcn_readlane(__float_as_int(a), 47));
                a += (lane >= 48) ? (t15 + t31 + t47) : (lane >= 32 ? (t15 + t31) : (lane >= 16 ? t15 : 0.f));
                const float cl = __int_as_float(__builtin_amdgcn_readlane(__float_as_int(a), 63));
                faw[lane] = a; faw[64 + lane] = __expf(a); faw[128 + lane] = __expf(cl - a) * dt; faw[192 + lane] = dt;
        }
        __syncthreads();
        for (int ci = 0; ci < NCH; ++ci) {
            if (ci + 1 < NCH) C_ISSUE(ci + 1);
            LAS float* fa = fab + (ci & 1) * 256;
            { const int ti = w >> 1, tj0 = (w & 1) * 2;
              f32x4 gacc[2] = {(f32x4){0.f, 0.f, 0.f, 0.f}, (f32x4){0.f, 0.f, 0.f, 0.f}};
#pragma unroll
              for (int kk = 0; kk < 4; ++kk) { const bf16x8 cf = *(const LAS bf16x8*)(Cm + (ti * 16 + fr) * SB + kk * 32 + fq * 8);
#pragma unroll
                  for (int t = 0; t < 2; ++t) { const bf16x8 bfg = *(const LAS bf16x8*)(Bm + ((tj0 + t) * 16 + fr) * SB + kk * 32 + fq * 8);
                      gacc[t] = __builtin_amdgcn_mfma_f32_16x16x32_bf16(bfg, cf, gacc[t], 0, 0, 0); } }
              const int i = ti * 16 + fr; const float cmi = fa[i];
#pragma unroll
              for (int t = 0; t < 2; ++t) { const int j0 = (tj0 + t) * 16 + fq * 4; float m[4];
                  const f32x4 cj4 = *(const LAS f32x4*)(fa + j0), dj4 = *(const LAS f32x4*)(fa + 192 + j0);
#pragma unroll
                  for (int jj = 0; jj < 4; ++jj) { const int j = j0 + jj; const float lv = __expf(fminf(cmi - cj4[jj], 0.f)) * dj4[jj]; m[jj] = (j <= i) ? gacc[t][jj] * lv : 0.f; }
                  u32x2 o; o.x = cvt_pk_bf16(m[0], m[1]); o.y = cvt_pk_bf16(m[2], m[3]);
                  *(LAS u32x2*)(Mm + i * SX + j0) = o; } }
            { const int pq = tid >> 3, j8 = (tid & 7) * 8; const u32x4 v = *(const LAS u32x4*)(XT + pq * SX + j8);
              const f32x4 wa = *(const LAS f32x4*)(fa + 128 + j8), wb = *(const LAS f32x4*)(fa + 128 + j8 + 4);
              u32x4 o; o.x = cvt_pk_bf16(bflo(v.x) * wa[0], bfhi(v.x) * wa[1]); o.y = cvt_pk_bf16(bflo(v.y) * wa[2], bfhi(v.y) * wa[3]);
              o.z = cvt_pk_bf16(bflo(v.z) * wb[0], bfhi(v.z) * wb[1]); o.w = cvt_pk_bf16(bflo(v.w) * wb[2], bfhi(v.w) * wb[3]);
              *(LAS u32x4*)(XsT + pq * SX + j8) = o; }
            LDS_BARRIER();
            { const int tp = w >> 1, ti0 = (w & 1) * 2;
              f32x4 a1[2] = {(f32x4){0.f, 0.f, 0.f, 0.f}, (f32x4){0.f, 0.f, 0.f, 0.f}}, a2[2] = {(f32x4){0.f, 0.f, 0.f, 0.f}, (f32x4){0.f, 0.f, 0.f, 0.f}};
#pragma unroll
              for (int kk = 0; kk < 2; ++kk) { const bf16x8 af = *(const LAS bf16x8*)(XT + (tp * 16 + fr) * SX + kk * 32 + fq * 8);
#pragma unroll
                  for (int t = 0; t < 2; ++t) { const bf16x8 mf = *(const LAS bf16x8*)(Mm + ((ti0 + t) * 16 + fr) * SX + kk * 32 + fq * 8);
                      a1[t] = __builtin_amdgcn_mfma_f32_16x16x32_bf16(af, mf, a1[t], 0, 0, 0); } }
#pragma unroll
              for (int kk = 0; kk < 4; ++kk) { const bf16x8 hf = *(const LAS bf16x8*)(Hb + (tp * 16 + fr) * SB + kk * 32 + fq * 8);
#pragma unroll
                  for (int t = 0; t < 2; ++t) { const bf16x8 cf = *(const LAS bf16x8*)(Cm + ((ti0 + t) * 16 + fr) * SB + kk * 32 + fq * 8);
                      a2[t] = __builtin_amdgcn_mfma_f32_16x16x32_bf16(hf, cf, a2[t], 0, 0, 0); } }
#pragma unroll
              for (int t = 0; t < 2; ++t) { const int i = (ti0 + t) * 16 + fr; const float ei = fa[64 + i];
                  int row, first, last; seqpos(ci * Q + i, dir, b, row, first, last);
                  const f32x4 yv = a1[t] + a2[t] * ei;
                  u32x2 o; o.x = cvt_pk_bf16(yv[0], yv[1]); o.y = cvt_pk_bf16(yv[2], yv[3]);
                  *(u32x2*)(Y + (size_t)row * DM + dir * 512 + h * 64 + tp * 16 + fq * 4) = o; } }
            if (w == 0 && ci + 1 < NCH) { LAS float* faw = fab + ((ci + 1) & 1) * 256;
                const float xx = dtraw + dtb; const float dt = xx > 20.f ? xx : log1pf(__expf(xx));
                float a = dt * Aneg;
                a = DPP_ADD(a, 0x111); a = DPP_ADD(a, 0x112); a = DPP_ADD(a, 0x114); a = DPP_ADD(a, 0x118);
                const float t15 = __int_as_float(__builtin_amdgcn_readlane(__float_as_int(a), 15));
                const float t31 = __int_as_float(__builtin_amdgcn_readlane(__float_as_int(a), 31));
                const float t47 = __int_as_float(__builtin_amdgcn_readlane(__float_as_int(a), 47));
                a += (lane >= 48) ? (t15 + t31 + t47) : (lane >= 32 ? (t15 + t31) : (lane >= 16 ? t15 : 0.f));
                const float cl = __int_as_float(__builtin_amdgcn_readlane(__float_as_int(a), 63));
                faw[lane] = a; faw[64 + lane] = __expf(a); faw[128 + lane] = __expf(cl - a) * dt; faw[192 + lane] = dt;
            }
            { const float decl = fa[64 + 63];
#pragma unroll
              for (int tp = 0; tp < 4; ++tp) Hacc[tp] = Hacc[tp] * decl;
#pragma unroll
              for (int kk = 0; kk < 2; ++kk) { const bf16x8 af = *(const LAS bf16x8*)(BT + (w * 16 + fr) * SX + kk * 32 + fq * 8);
#pragma unroll
                  for (int tp = 0; tp < 4; ++tp) { const bf16x8 xf = *(const LAS bf16x8*)(XsT + (tp * 16 + fr) * SX + kk * 32 + fq * 8);
                      Hacc[tp] = __builtin_amdgcn_mfma_f32_16x16x32_bf16(af, xf, Hacc[tp], 0, 0, 0); } } }
            LDS_BARRIER();
#pragma unroll
            for (int tp = 0; tp < 4; ++tp) { u32x2 o; o.x = cvt_pk_bf16(Hacc[tp][0], Hacc[tp][1]); o.y = cvt_pk_bf16(Hacc[tp][2], Hacc[tp][3]);
                *(LAS u32x2*)(Hb + (tp * 16 + fr) * SB + w * 16 + fq * 4) = o; }
            if (ci + 1 < NCH) C_STORE();
            dtcur = dtraw;
            LDS_BARRIER();
        }
#undef C_ISSUE
#undef C_STORE
    }
}

__device__ __forceinline__ void mamba_post_phase(const P& p, int l, int r0) {
    const int lane = opq_tid() & 63, wid = opq_tid() >> 6;
    const bf16_t* PM = (const bf16_t*)(p.ws + OFF_PM);
    bf16_t* Y = (bf16_t*)(p.ws + OFF_Y);
    const int ch = lane * 8;
    const float Dh = p.in[16][l * 8 + (lane >> 3)];
    const f32x4 nw0 = *(const f32x4*)(p.in[17] + l * 512 + ch), nw1 = *(const f32x4*)(p.in[17] + l * 512 + ch + 4);
    const bf16_t* XBCp = (const bf16_t*)(p.ws + OFF_HN);
    u32x4 yFA, yBA, zzA, xsA, yFB, yBB, zzB, xsB;
#define MQ_LOAD(X, row_) do { yF##X = *(const u32x4*)(Y + (size_t)(row_) * DM + ch); yB##X = *(const u32x4*)(Y + (size_t)(row_) * DM + 512 + ch); \
        zz##X = *(const u32x4*)(PM + (size_t)(row_) * PMW + ch); xs##X = *(const u32x4*)(XBCp + (size_t)(row_) * 1024 + ch); } while (0)
#define MQ_COMPUTE(X, row_) do { float y[8]; float ss = 0.f; \
        _Pragma("unroll") for (int e = 0; e < 8; ++e) { float t = bfe(yF##X, e) + bfe(yB##X, e) + Dh * bfe(xs##X, e); t *= siluf_(bfe(zz##X, e)); y[e] = t; ss += t * t; } \
        ss += __shfl_xor(ss, 1); ss += __shfl_xor(ss, 2); ss += __shfl_xor(ss, 4); ss += __shfl_xor(ss, 8); ss += __shfl_xor(ss, 16); \
        const float rstd = rsqrtf(ss * (1.f / 256.f) + EPS); u32x4 o; \
        o.x = cvt_pk_bf16(y[0] * rstd * nw0[0], y[1] * rstd * nw0[1]); o.y = cvt_pk_bf16(y[2] * rstd * nw0[2], y[3] * rstd * nw0[3]); \
        o.z = cvt_pk_bf16(y[4] * rstd * nw1[0], y[5] * rstd * nw1[1]); o.w = cvt_pk_bf16(y[6] * rstd * nw1[2], y[7] * rstd * nw1[3]); \
        *(u32x4*)(Y + (size_t)(row_) * DM + ch) = o; } while (0)
    const int rstep = (int)gridDim.x * 8;
    int row = r0 + opq_bid() * 8 + wid;
    if (row < R) MQ_LOAD(A, row);
    while (row < R) {
        int rn = row + rstep;
        if (rn < R) MQ_LOAD(B, rn);
        __builtin_amdgcn_sched_barrier(0);
        MQ_COMPUTE(A, row);
        __builtin_amdgcn_sched_barrier(0);
        row = rn; if (row >= R) break;
        rn = row + rstep;
        if (rn < R) MQ_LOAD(A, rn);
        __builtin_amdgcn_sched_barrier(0);
        MQ_COMPUTE(B, row);
        __builtin_amdgcn_sched_barrier(0);
        row = rn;
    }
#undef MQ_LOAD
#undef MQ_COMPUTE
}

template <int MM>
__device__ __forceinline__ void prep_mm(const P& p, int l, int row0, int w, int fr, int fq, const LAS bf16_t* XW, const LAS bf16_t* XA, const LAS bf16_t* XG,
                                        const bf16_t* W2t, const bf16_t* A2t, const bf16_t* G2t, bf16_t* D4, bf16_t* G) {
    constexpr int LX = 72, LG = 168, TT = 48, NTS = TT / 16;
    constexpr int d = MM & 1, K = MM < 4 ? 64 : 160, LDX = MM < 4 ? LX : LG, NK = K / 32;
    const LAS bf16_t* X = MM < 2 ? XW + d * TT * LX : (MM < 4 ? XA + d * TT * LX : XG);
    const bf16_t* Wt = MM < 2 ? W2t + d * 512 * 64 : (MM < 4 ? A2t + d * 512 * 64 : G2t);
    f32x4 bias[4];
#pragma unroll
    for (int ns = 0; ns < 4; ++ns) { const int ch = w * 64 + ns * 16 + fq * 4;
        bias[ns] = MM < 2 ? *(const f32x4*)(p.in[19] + (size_t)(l * 2 + d) * 512 + ch) : (MM < 4 ? *(const f32x4*)(p.in[21] + (size_t)(l * 2 + d) * 512 + ch) : (f32x4){0.f, 0.f, 0.f, 0.f}); }
    f32x4 acc[NTS][4];
#pragma unroll
    for (int a = 0; a < NTS; ++a)
#pragma unroll
        for (int c = 0; c < 4; ++c) acc[a][c] = (f32x4){0.f, 0.f, 0.f, 0.f};
#pragma unroll
    for (int k0 = 0; k0 < NK; k0 += 2) {
        bf16x8 af[2][4], bfr[2][NTS];
#pragma unroll
        for (int k2 = 0; k2 < 2; ++k2) if (k0 + k2 < NK) {
#pragma unroll
            for (int ns = 0; ns < 4; ++ns) af[k2][ns] = *(const bf16x8*)(Wt + (size_t)(w * 64 + ns * 16 + fr) * K + (k0 + k2) * 32 + fq * 8);
#pragma unroll
            for (int ts = 0; ts < NTS; ++ts) bfr[k2][ts] = *(const LAS bf16x8*)(X + (ts * 16 + fr) * LDX + (k0 + k2) * 32 + fq * 8); }
#pragma unroll
        for (int k2 = 0; k2 < 2; ++k2) if (k0 + k2 < NK) {
#pragma unroll
            for (int ts = 0; ts < NTS; ++ts)
#pragma unroll
                for (int ns = 0; ns < 4; ++ns) acc[ts][ns] = __builtin_amdgcn_mfma_f32_16x16x32_bf16(af[k2][ns], bfr[k2][ts], acc[ts][ns], 0, 0, 0); }
    }
#pragma unroll
    for (int ts = 0; ts < NTS; ++ts)
#pragma unroll
        for (int ns = 0; ns < 4; ++ns) {
            const int row = row0 + ts * 16 + fr, ch = w * 64 + ns * 16 + fq * 4;
            f32x4 v = acc[ts][ns];
            if (MM < 2) {
#pragma unroll
                for (int e = 0; e < 4; ++e) v[e] = -0.6065306597126334f * sigmoidf_(bias[ns][e] + v[e]); }
            else if (MM < 4) {
#pragma unroll
                for (int e = 0; e < 4; ++e) v[e] = sigmoidf_(bias[ns][e] + v[e]); }
            u32x2 o; o.x = cvt_pk_bf16(v[0], v[1]); o.y = cvt_pk_bf16(v[2], v[3]);
            bf16_t* dst = MM < 2 ? D4 + (size_t)row * 2048 + d * 512 + ch : (MM < 4 ? D4 + (size_t)row * 2048 + 1024 + d * 512 + ch : G + (size_t)row * 512 + ch);
            *(u32x2*)dst = o;
        }
}
__device__ __forceinline__ void rwkv_prep_phase(LAS unsigned char* lds, const P& p, int l) {
    constexpr int LX = 72, LG = 168, NIT = 4, TT = 48;
    LAS bf16_t* XW = (LAS bf16_t*)lds;
    LAS bf16_t* XA = XW + 2 * TT * LX;
    LAS bf16_t* XG = XA + 2 * TT * LX;
    const int tid = opq_tid(), lane = tid & 63, w = tid >> 6, fr = lane & 15, fq = lane >> 4;
    const bf16_t* PR = (const bf16_t*)(p.ws + OFF_PR);
    bf16_t* D4 = (bf16_t*)(p.ws + OFF_D4); bf16_t* G = (bf16_t*)(p.ws + OFF_G);
    const bf16_t* W2t = (const bf16_t*)(p.ws + OFF_LORA); const bf16_t* A2t = W2t + 2 * 512 * 64; const bf16_t* G2t = A2t + 2 * 512 * 64;
    const float* mu = p.in[18] + (size_t)l * RCOLS;
    for (int tile = opq_bid(); tile < R / TT; tile += gridDim.x) {
        const int row0 = tile * TT;
        __syncthreads();
#pragma unroll 1
        for (int bi = 0; bi < 2; ++bi) {
        u32x4 cu[NIT], pv[NIT], nv[NIT];
#pragma unroll
        for (int i = 0; i < NIT; ++i) {
            const int it = tid + (bi * NIT + i) * 512; const bool valid = it < TT * 52;
            const int j = it / 52, cgi = it % 52, row = row0 + j, col = 1536 + cgi * 8;
            int first, last, mrow; row_info(row, first, last, mrow);
            const u32x4 z4 = (u32x4){0u, 0u, 0u, 0u};
            if (valid) { const bf16_t* src = PR + (size_t)row * PRW + col;
                cu[i] = *(const u32x4*)src; pv[i] = first ? z4 : *(const u32x4*)(src - PRW); nv[i] = last ? z4 : *(const u32x4*)(src + PRW); }
            else { cu[i] = z4; pv[i] = z4; nv[i] = z4; }
        }
#pragma unroll
        for (int i = 0; i < NIT; ++i) {
            const int it = tid + (bi * NIT + i) * 512; const bool valid = it < TT * 52;
            const int j = it / 52, cgi = it % 52;
            const f32x4 m0 = *(const f32x4*)(mu + 1536 + cgi * 8), m1 = *(const f32x4*)(mu + 1536 + cgi * 8 + 4);
            float s[8];
#pragma unroll
            for (int e = 0; e < 8; ++e) { const float u = bfe(cu[i], e); const float mm_ = e < 4 ? m0[e & 3] : m1[e & 3]; s[e] = u + mm_ * (0.5f * (bfe(pv[i], e) + bfe(nv[i], e)) - u); }
            LAS bf16_t* dst;
            if (cgi < 16) { const int d = cgi >> 3, kk = (cgi & 7) * 8; dst = XW + (d * TT + j) * LX + kk;
#pragma unroll
                for (int e = 0; e < 8; ++e) s[e] = tanhf_(s[e]); }
            else if (cgi < 32) { const int c2 = cgi - 16, d = c2 >> 3, kk = (c2 & 7) * 8; dst = XA + (d * TT + j) * LX + kk; }
            else { const int kk = (cgi - 32) * 8; dst = XG + j * LG + kk;
#pragma unroll
                for (int e = 0; e < 8; ++e) s[e] = sigmoidf_(s[e]); }
            u32x4 o; o.x = cvt_pk_bf16(s[0], s[1]); o.y = cvt_pk_bf16(s[2], s[3]); o.z = cvt_pk_bf16(s[4], s[5]); o.w = cvt_pk_bf16(s[6], s[7]);
            if (valid) *(LAS u32x4*)dst = o;
        }
        }
        __syncthreads();
        prep_mm<0>(p, l, row0, w, fr, fq, XW, XA, XG, W2t, A2t, G2t, D4, G);
        __builtin_amdgcn_sched_barrier(0);
        prep_mm<1>(p, l, row0, w, fr, fq, XW, XA, XG, W2t, A2t, G2t, D4, G);
        __builtin_amdgcn_sched_barrier(0);
        prep_mm<2>(p, l, row0, w, fr, fq, XW, XA, XG, W2t, A2t, G2t, D4, G);
        __builtin_amdgcn_sched_barrier(0);
        prep_mm<3>(p, l, row0, w, fr, fq, XW, XA, XG, W2t, A2t, G2t, D4, G);
        __builtin_amdgcn_sched_barrier(0);
        prep_mm<4>(p, l, row0, w, fr, fq, XW, XA, XG, W2t, A2t, G2t, D4, G);
    }
}

__device__ __forceinline__ void rwkv_scan_phase(LAS unsigned char* lds, const P& p, int l) {
    constexpr int T = 32, NCH = (CTX + SEQ) / T, BUF = 6 * T * 64;
    LAS float* base = (LAS float*)lds;
    LAS float* ob = base + 2 * BUF;
    const int tid = opq_tid();
    const bf16_t* PR = (const bf16_t*)(p.ws + OFF_PR);
    bf16_t* D4 = (bf16_t*)(p.ws + OFF_D4);
    const float* mu = p.in[18] + (size_t)l * RCOLS;
    for (int q = opq_bid(); q < 256; q += gridDim.x) {
        const int b = q >> 4, h = (q >> 1) & 7, dir = q & 1;
        const int vv_ = tid >> 3, part = tid & 7;
        f32x2 S2[2][4];
#pragma unroll
        for (int i = 0; i < 4; ++i) { S2[0][i] = (f32x2){0.f, 0.f}; S2[1][i] = (f32x2){0.f, 0.f}; }
        const int w = tid >> 6, rp = (tid >> 3) & 31;
        const int lj = tid >> 4, c4 = (tid & 15) * 4, hc = h * 64 + c4;
        f32x4 mur, muk, muv, kkw, kaw, rkw;
#pragma unroll
        for (int e = 0; e < 4; ++e) { mur[e] = mu[hc + e]; muk[e] = mu[512 + hc + e]; muv[e] = mu[1024 + hc + e];
            kkw[e] = p.in[24][l * 512 + hc + e]; kaw[e] = p.in[25][l * 512 + hc + e]; rkw[e] = p.in[26][l * 512 + hc + e]; }
        float* BON = (float*)(p.ws + OFF_DT);
        u32x2 lrA[3], lkA[3], lvA[3], llwA, laA, lrB[3], lkB[3], lvB[3], llwB, laB;
#define R_ISSUE(ci, LJ, X) do { int row, first, last; seqpos((ci) * T + (LJ), dir, b, row, first, last); const u32x2 z2 = (u32x2){0u, 0u}; \
            const bf16_t* src = PR + (size_t)row * PRW + hc; \
            lr##X[1] = *(const u32x2*)src; lk##X[1] = *(const u32x2*)(src + 512); lv##X[1] = *(const u32x2*)(src + 1024); \
            if (first) { lr##X[0] = z2; lk##X[0] = z2; lv##X[0] = z2; } else { lr##X[0] = *(const u32x2*)(src - PRW); lk##X[0] = *(const u32x2*)(src - PRW + 512); lv##X[0] = *(const u32x2*)(src - PRW + 1024); } \
            if (last) { lr##X[2] = z2; lk##X[2] = z2; lv##X[2] = z2; } else { lr##X[2] = *(const u32x2*)(src + PRW); lk##X[2] = *(const u32x2*)(src + PRW + 512); lv##X[2] = *(const u32x2*)(src + PRW + 1024); } \
            llw##X = *(const u32x2*)(D4 + (size_t)row * 2048 + dir * 512 + hc); la##X = *(const u32x2*)(D4 + (size_t)row * 2048 + 1024 + dir * 512 + hc); } while (0)
#define R_PROCESS(ci, LJ, X) do { LAS float* bb = base + ((ci) & 1) * BUF + (LJ) * 64 + c4; \
            f32x4 rr, kx, vx, kkv, av, wv; float ss = 0.f; \
            _Pragma("unroll") for (int e = 0; e < 4; ++e) { \
                const float ur = bfe2(lr##X[1], e), uk = bfe2(lk##X[1], e), uv = bfe2(lv##X[1], e); \
                rr[e] = ur + mur[e] * (0.5f * (bfe2(lr##X[0], e) + bfe2(lr##X[2], e)) - ur); \
                kx[e] = uk + muk[e] * (0.5f * (bfe2(lk##X[0], e) + bfe2(lk##X[2], e)) - uk); \
                vx[e] = uv + muv[e] * (0.5f * (bfe2(lv##X[0], e) + bfe2(lv##X[2], e)) - uv); \
                kkv[e] = kx[e] * kkw[e]; ss += kkv[e] * kkv[e]; av[e] = bfe2(la##X, e); wv[e] = __expf(bfe2(llw##X, e)); } \
            ss = red16(ss); \
            const float inv = 1.f / fmaxf(sqrtf(ss), 1e-12f); \
            f32x4 bv, kdv, nkk; \
            float bsum = 0.f; \
            _Pragma("unroll") for (int e = 0; e < 4; ++e) { kkv[e] *= inv; bv[e] = kkv[e] * av[e]; nkk[e] = -kkv[e]; kdv[e] = kx[e] * (1.f + (av[e] - 1.f) * kaw[e]); bsum += rr[e] * kdv[e] * rkw[e]; } \
            bsum = red16(bsum); \
            if ((tid & 15) == 0) { int row_, f_, l_; seqpos((ci) * T + (LJ), dir, b, row_, f_, l_); BON[((size_t)dir * R + row_) * 8 + h] = bsum; } \
            *(LAS f32x4*)(bb + 0 * T * 64) = wv; *(LAS f32x4*)(bb + 1 * T * 64) = bv; *(LAS f32x4*)(bb + 2 * T * 64) = kdv; \
            *(LAS f32x4*)(bb + 3 * T * 64) = nkk; *(LAS f32x4*)(bb + 4 * T * 64) = rr; *(LAS f32x4*)(bb + 5 * T * 64) = vx; } while (0)
#define R_FLUSH(cc, LJ) do { int row, first, last; seqpos((cc) * T + (LJ), dir, b, row, first, last); \
            const f32x4 ov = *(const LAS f32x4*)(ob + ((cc) & 1) * T * 64 + (LJ) * 64 + c4); \
            u32x2 o2; o2.x = cvt_pk_bf16(ov[0], ov[1]); o2.y = cvt_pk_bf16(ov[2], ov[3]); \
            *(u32x2*)(D4 + (size_t)row * 2048 + dir * 512 + hc) = o2; } while (0)
        const int ljA = (tid - 256) >> 4, ljB = ljA + 16;
        __syncthreads();
        R_ISSUE(0, lj, A); R_PROCESS(0, lj, A);
        __syncthreads();
        for (int ci = 0; ci < NCH; ++ci) {
            const LAS float* cb = base + (ci & 1) * BUF;
            LAS float* obw = ob + (ci & 1) * T * 64;
            if (w < 4) {
#define RV_LOAD(P_, j_) do { const LAS float* pj = cb + (j_) * 64 + part * 4; \
                P_##w0 = *(const LAS f32x4*)(pj); P_##w1 = *(const LAS f32x4*)(pj + 32); \
                P_##b0 = *(const LAS f32x4*)(pj + T * 64); P_##b1 = *(const LAS f32x4*)(pj + T * 64 + 32); \
                P_##k0 = *(const LAS f32x4*)(pj + 2 * T * 64); P_##k1 = *(const LAS f32x4*)(pj + 2 * T * 64 + 32); \
                P_##n0 = *(const LAS f32x4*)(pj + 3 * T * 64); P_##n1 = *(const LAS f32x4*)(pj + 3 * T * 64 + 32); \
                P_##r0 = *(const LAS f32x4*)(pj + 4 * T * 64); P_##r1 = *(const LAS f32x4*)(pj + 4 * T * 64 + 32); \
                P_##vt = *(const LAS f32x2*)(cb + 5 * T * 64 + (j_) * 64 + rp * 2); } while (0)
#define RV_V4(x_) {(f32x2){x_##0[0], x_##0[1]}, (f32x2){x_##0[2], x_##0[3]}, (f32x2){x_##1[0], x_##1[1]}, (f32x2){x_##1[2], x_##1[3]}}
#define RV_COMPUTE(P_, jj_) do { const f32x2 w_[4] = RV_V4(P_##w), b_[4] = RV_V4(P_##b), k_[4] = RV_V4(P_##k), n_[4] = RV_V4(P_##n), r_[4] = RV_V4(P_##r); \
                _Pragma("unroll") for (int u = 0; u < 2; ++u) { \
                    f32x2 sa2 = S2[u][0] * n_[0]; sa2 = S2[u][1] * n_[1] + sa2; sa2 = S2[u][2] * n_[2] + sa2; sa2 = S2[u][3] * n_[3] + sa2; \
                    const float sa = red8(sa2[0] + sa2[1]); \
                    const f32x2 sav = (f32x2){sa, sa}, vtv = (f32x2){P_##vt[u], P_##vt[u]}; \
                    f32x2 o2 = (f32x2){0.f, 0.f}; \
                    _Pragma("unroll") for (int q2 = 0; q2 < 4; ++q2) { f32x2 t = vtv * k_[q2]; t = sav * b_[q2] + t; S2[u][q2] = S2[u][q2] * w_[q2] + t; o2 = S2[u][q2] * r_[q2] + o2; } \
                    const float o = red8(o2[0] + o2[1]); \
                    if (part == (jj_)) ocap[u] = o; } } while (0)
                f32x4 Aw0, Aw1, Ab0, Ab1, Ak0, Ak1, An0, An1, Ar0, Ar1, Bw0, Bw1, Bb0, Bb1, Bk0, Bk1, Bn0, Bn1, Br0, Br1; f32x2 Avt, Bvt;
                __builtin_amdgcn_s_setprio(3);
                RV_LOAD(A, 0);
#pragma unroll 1
                for (int j0 = 0; j0 < T; j0 += 8) {
                    f32x2 ocap = (f32x2){0.f, 0.f};
#pragma unroll
                    for (int jj = 0; jj < 8; jj += 2) {
                        RV_LOAD(B, j0 + jj + 1);
                        __builtin_amdgcn_sched_barrier(0);
                        RV_COMPUTE(A, jj);
                        __builtin_amdgcn_sched_barrier(0);
                        if (j0 + jj + 2 < T) RV_LOAD(A, j0 + jj + 2);
                        __builtin_amdgcn_sched_barrier(0);
                        RV_COMPUTE(B, jj + 1);
                        __builtin_amdgcn_sched_barrier(0);
                    }
                    *(LAS f32x2*)(obw + (j0 + part) * 64 + rp * 2) = ocap;
                }
                __builtin_amdgcn_s_setprio(0);
#undef RV_LOAD
#undef RV_V4
#undef RV_COMPUTE
            }
            else {
                if (ci + 1 < NCH) { R_ISSUE(ci + 1, ljA, A); R_ISSUE(ci + 1, ljB, B); }
                if (ci > 0) { R_FLUSH(ci - 1, ljA); R_FLUSH(ci - 1, ljB); }
                if (ci + 1 < NCH) { R_PROCESS(ci + 1, ljA, A); R_PROCESS(ci + 1, ljB, B); }
            }
            LDS_BARRIER();
        }
        if (w >= 4) { R_FLUSH(NCH - 1, ljA); R_FLUSH(NCH - 1, ljB); }
#undef R_FLUSH
#undef R_ISSUE
#undef R_PROCESS
    }
}

__device__ __forceinline__ void rwkv_post_phase(const P& p, int l, int r0) {
    const int lane = opq_tid() & 63, wid = opq_tid() >> 6;
    const bf16_t* PR = (const bf16_t*)(p.ws + OFF_PR);
    const bf16_t* D4 = (const bf16_t*)(p.ws + OFF_D4); const bf16_t* G = (const bf16_t*)(p.ws + OFF_G);
    bf16_t* Y = (bf16_t*)(p.ws + OFF_Y);
    const float* mu = p.in[18] + (size_t)l * RCOLS;
    const int ch = lane * 8;
    float mur[8], muk[8], muv[8], kaw[8], rkw[8], lnw[8], lnb[8];
#pragma unroll
    for (int hh = 0; hh < 2; ++hh) {
        const f32x4 a0 = *(const f32x4*)(mu + ch + hh * 4), a1 = *(const f32x4*)(mu + 512 + ch + hh * 4), a2 = *(const f32x4*)(mu + 1024 + ch + hh * 4);
        const f32x4 a3 = *(const f32x4*)(p.in[25] + l * 512 + ch + hh * 4), a4 = *(const f32x4*)(p.in[26] + l * 512 + ch + hh * 4);
        const f32x4 a5 = *(const f32x4*)(p.in[27] + l * 512 + ch + hh * 4), a6 = *(const f32x4*)(p.in[28] + l * 512 + ch + hh * 4);
#pragma unroll
        for (int e = 0; e < 4; ++e) { mur[hh * 4 + e] = a0[e]; muk[hh * 4 + e] = a1[e]; muv[hh * 4 + e] = a2[e]; kaw[hh * 4 + e] = a3[e]; rkw[hh * 4 + e] = a4[e]; lnw[hh * 4 + e] = a5[e]; lnb[hh * 4 + e] = a6[e]; }
    }
    const float* BON = (const float*)(p.ws + OFF_DT);
    const u32x4 z4 = (u32x4){0u, 0u, 0u, 0u};
    u32x4 vcA, vpA, vnA, oFA, oBA, ggA, vcB, vpB, vnB, oFB, oBB, ggB; float b0A, b1A, b0B, b1B; int flA = 0, flB = 0;
#define RQ_LOAD(X, row_) do { int f_, l_, m_; row_info(row_, f_, l_, m_); const bf16_t* src = PR + (size_t)(row_) * PRW + 1024 + ch; \
        vc##X = *(const u32x4*)src; vp##X = *(const u32x4*)(src - (f_ ? 0 : PRW)); vn##X = *(const u32x4*)(src + (l_ ? 0 : PRW)); fl##X = f_ | (l_ << 1); \
        const bf16_t* d4 = D4 + (size_t)(row_) * 2048 + ch; oF##X = *(const u32x4*)d4; oB##X = *(const u32x4*)(d4 + 512); \
        gg##X = *(const u32x4*)(G + (size_t)(row_) * 512 + ch); \
        b0##X = BON[(size_t)(row_) * 8 + (lane >> 3)]; b1##X = BON[((size_t)R + (row_)) * 8 + (lane >> 3)]; } while (0)
#define RQ_COMPUTE(X, row_) do { const float bs = b0##X + b1##X; float o[8], vx[8]; float sum = 0.f; const u32x4 vp_ = (fl##X & 1) ? z4 : vp##X, vn_ = (fl##X & 2) ? z4 : vn##X; \
        _Pragma("unroll") for (int e = 0; e < 8; ++e) { const float uv = bfe(vc##X, e); \
            vx[e] = uv + muv[e] * (0.5f * (bfe(vp_, e) + bfe(vn_, e)) - uv); o[e] = bfe(oF##X, e) + bfe(oB##X, e); sum += o[e]; } \
        sum = red8(sum); const float mean = sum * (1.f / 64.f); float var = 0.f; \
        _Pragma("unroll") for (int e = 0; e < 8; ++e) { o[e] -= mean; var += o[e] * o[e]; } \
        var = red8(var); const float rstd = rsqrtf(var * (1.f / 64.f) + 64e-5f); float out[8]; \
        _Pragma("unroll") for (int e = 0; e < 8; ++e) { const float on = o[e] * rstd * lnw[e] + lnb[e]; out[e] = (on + bs * vx[e]) * bfe(gg##X, e); } \
        u32x4 w; w.x = cvt_pk_bf16(out[0], out[1]); w.y = cvt_pk_bf16(out[2], out[3]); w.z = cvt_pk_bf16(out[4], out[5]); w.w = cvt_pk_bf16(out[6], out[7]); \
        *(u32x4*)(Y + (size_t)(row_) * DM + 512 + ch) = w; } while (0)
    const int rstep = (int)gridDim.x * 8;
    int row = r0 + opq_bid() * 8 + wid;
    if (row < R) RQ_LOAD(A, row);
    while (row < R) {
        int rn = row + rstep;
        if (rn < R) RQ_LOAD(B, rn);
        __builtin_amdgcn_sched_barrier(0);
        RQ_COMPUTE(A, row);
        __builtin_amdgcn_sched_barrier(0);
        row = rn; if (row >= R) break;
        rn = row + rstep;
        if (rn < R) RQ_LOAD(A, rn);
        __builtin_amdgcn_sched_barrier(0);
        RQ_COMPUTE(B, row);
        __builtin_amdgcn_sched_barrier(0);
        row = rn;
    }
#undef RQ_LOAD
#undef RQ_COMPUTE
}

__device__ __forceinline__ void gate_phase(const P& p, int l, int r0, int gvbase) {
    bf16_t* GV = (bf16_t*)(p.ws + OFF_GV);
    const float* cwt = p.in[30] + (size_t)l * 9 * DFF; const float* cbs = p.in[31] + (size_t)l * DFF;
    const int nstrip_ctx = (r0 < RC) ? RC / 16 : 0, nstrip = nstrip_ctx + RL / 16;
    const int gthr = opq_bid() * 512 + opq_tid(), nslots = ((int)gridDim.x * 512) / 352;
    const int c8 = (gthr % 352) * 8, s0 = gthr / 352;
    f32x4 wa[9], wb[9];
#pragma unroll
    for (int k = 0; k < 9; ++k) { wa[k] = *(const f32x4*)(cwt + (size_t)k * DFF + c8); wb[k] = *(const f32x4*)(cwt + (size_t)k * DFF + c8 + 4); }
    const f32x4 ba = *(const f32x4*)(cbs + c8), bb = *(const f32x4*)(cbs + c8 + 4);
    for (int sid = (s0 < nslots ? s0 : nstrip); sid < nstrip; sid += nslots) {
        int row0, Wd, Hh, yy, x0;
        if (sid < nstrip_ctx) { row0 = sid * 16; Wd = CTX; Hh = 1; yy = 0; x0 = row0 & (CTX - 1); }
        else { const int r2 = (sid - nstrip_ctx) * 16; row0 = RC + r2; Wd = 64; Hh = 32; const int t = r2 & (SEQ - 1); yy = t >> 6; x0 = t & 63; }
        const bool vup = (yy > 0), vdn = (yy + 1 < Hh);
        const bf16_t* gp = GV + (size_t)(row0 - gvbase) * NUP + c8;
        const u32x4 z4 = (u32x4){0u, 0u, 0u, 0u};
        const long upo = vup ? -(long)Wd * NUP : 0, dno = vdn ? (long)Wd * NUP : 0;
        constexpr int GD = 3;
        u32x4 col[18][3], val[16];
#define G_COL(dst, dx, ok) do { const bool _ok = (ok); const bf16_t* q = gp + (long)(_ok ? (dx) : 0) * NUP; \
            const u32x4 _a = *(const u32x4*)(q + upo), _b = *(const u32x4*)q, _c = *(const u32x4*)(q + dno); \
            dst[0] = (_ok && vup) ? _a : z4; dst[1] = _ok ? _b : z4; dst[2] = (_ok && vdn) ? _c : z4; } while (0)
        G_COL(col[0], -1, x0 > 0);
#pragma unroll
        for (int k = 0; k <= GD; ++k) G_COL(col[k + 1], k, x0 + k < Wd);
#pragma unroll
        for (int k = 0; k < GD; ++k) val[k] = *(const u32x4*)(gp + (long)k * NUP + DFF);
#pragma unroll
        for (int i = 0; i < 16; ++i) {
            if (i + GD + 1 <= 16) G_COL(col[i + GD + 2], i + GD + 1, x0 + i + GD + 1 < Wd);
            if (i + GD < 16) val[i + GD] = *(const u32x4*)(gp + (long)(i + GD) * NUP + DFF);
            float acc[8];
#pragma unroll
            for (int e = 0; e < 4; ++e) { acc[e] = ba[e]; acc[4 + e] = bb[e]; }
#pragma unroll
            for (int ky = 0; ky < 3; ++ky)
#pragma unroll
                for (int e = 0; e < 4; ++e) {
                    acc[e] += wa[ky * 3 + 0][e] * bfe(col[i][ky], e) + wa[ky * 3 + 1][e] * bfe(col[i + 1][ky], e) + wa[ky * 3 + 2][e] * bfe(col[i + 2][ky], e);
                    acc[4 + e] += wb[ky * 3 + 0][e] * bfe(col[i][ky], 4 + e) + wb[ky * 3 + 1][e] * bfe(col[i + 1][ky], 4 + e) + wb[ky * 3 + 2][e] * bfe(col[i + 2][ky], 4 + e); }
            float o[8];
#pragma unroll
            for (int e = 0; e < 8; ++e) { const float x = acc[e]; const float u2 = 1.5957691216057308f * (x + 0.044715f * x * x * x);
                o[e] = x * __builtin_amdgcn_rcpf(1.f + __expf(-u2)) * bfe(val[i], e); }
            u32x4 w; w.x = cvt_pk_bf16(o[0], o[1]); w.y = cvt_pk_bf16(o[2], o[3]); w.z = cvt_pk_bf16(o[4], o[5]); w.w = cvt_pk_bf16(o[6], o[7]);
            *(u32x4*)(GV + (size_t)(row0 + i - gvbase) * NUP + DFF + c8) = w;
        }
#undef G_COL
    }
}

__global__ void __launch_bounds__(512, 2) fwd_megakernel(P p) {
    extern __shared__ __attribute__((aligned(16))) unsigned char lds_raw[];
    LAS unsigned char* lds = (LAS unsigned char*)lds_raw;
    cg::grid_group grid = cg::this_grid();
    unsigned char* ws = p.ws;
    float* ctxres = (float*)(ws + OFF_CTX);
    bf16_t* HN = (bf16_t*)(ws + OFF_HN); bf16_t* HN2 = (bf16_t*)(ws + OFF_HN2);
    bf16_t* PMp = (bf16_t*)(ws + OFF_PM); bf16_t* PRp = (bf16_t*)(ws + OFF_PR); float* DTp = (float*)(ws + OFF_DT);
    bf16_t* Yp = (bf16_t*)(ws + OFF_Y); bf16_t* MRAW = (bf16_t*)(ws + OFF_MRAW); bf16_t* GV = (bf16_t*)(ws + OFF_GV);
    const bf16_t* WIN = (const bf16_t*)(ws + OFF_WIN); const bf16_t* WOUT = (const bf16_t*)(ws + OFF_WOUT);
    const bf16_t* WUP = (const bf16_t*)(ws + OFF_WUP); const bf16_t* WDN = (const bf16_t*)(ws + OFF_WDN);
    const int G = gridDim.x, c = blockIdx.x;
    volatile LAS unsigned* xst = (volatile LAS unsigned*)(lds + 131072);
    if (threadIdx.x < 2) xst[threadIdx.x] = 0u;
    __syncthreads();
    (void)xcd_barrier_post((unsigned*)(ws + OFF_BAR), xst);

    mod_phase(lds, p);
    convert_weights(lds, p, 0);
    grid.sync();
    row_phase<false, true>(p, 0, 0, 0, R, p.in[0], p.in[2], nullptr, 0, 0, nullptr, 0, nullptr, nullptr, p.in[6], 0, HN, 0);
    xcd_barrier((unsigned*)(ws + OFF_BAR), (volatile LAS unsigned*)(lds + 131072));
#pragma unroll 1
    for (int l = 0; l < 2; ++l) {
        const float* xlat = l == 0 ? p.in[0] : p.out;
        const float* xctx = l == 0 ? p.in[2] : ctxres;
        { pg8::Gemm g{HN, WIN, R, NIN, DM, DM}; pg8::StaticOrder S; S.init(R, NIN, G, c, WGM_IN); pg8::EpiInProj E{PMp, PRp, DTp}; pg8::gemm_phase(lds, g, S, E); }
        xcd_barrier((unsigned*)(ws + OFF_BAR), (volatile LAS unsigned*)(lds + 131072));
        xbc_phase(p, l);
        xcd_barrier((unsigned*)(ws + OFF_BAR), (volatile LAS unsigned*)(lds + 131072));
        mamba_chunk_phase(lds, p, l);
        xcd_barrier((unsigned*)(ws + OFF_BAR), (volatile LAS unsigned*)(lds + 131072));
        mamba_post_phase(p, l, l == 0 ? 0 : RC);
        xcd_barrier((unsigned*)(ws + OFF_BAR), (volatile LAS unsigned*)(lds + 131072));
        rwkv_prep_phase(lds, p, l);
        xcd_barrier((unsigned*)(ws + OFF_BAR), (volatile LAS unsigned*)(lds + 131072));
        rwkv_scan_phase(lds, p, l);
        xcd_barrier((unsigned*)(ws + OFF_BAR), (volatile LAS unsigned*)(lds + 131072));
        rwkv_post_phase(p, l, l == 0 ? 0 : RC);
        xcd_barrier((unsigned*)(ws + OFF_BAR), (volatile LAS unsigned*)(lds + 131072));
        const int rs = l == 0 ? 0 : RC;
        { pg8::Gemm g{Yp + (size_t)rs * DM, WOUT, R - rs, DM, DM, DM}; pg8::StaticOrder S; S.init(R - rs, DM, G, c, WGM_OUT); pg8::EpiStore E{MRAW + (size_t)rs * DM, DM}; pg8::gemm_phase(lds, g, S, E); }
        xcd_barrier((unsigned*)(ws + OFF_BAR), (volatile LAS unsigned*)(lds + 131072));
        const int nrange = l == 0 ? 2 : 1;
        const int f0 = rs, f1 = l == 0 ? 32768 : R;
        row_phase<true, true>(p, l, l, f0, f1, xlat, xctx, MRAW, DM, 0, p.in[7] + l * DM, 2048, p.out, ctxres, p.in[8] + l * DM, 3072, HN2, f0);
        if (f1 < R) row_phase<true, false>(p, l, l, f1, R, xlat, xctx, MRAW, DM, 0, p.in[7] + l * DM, 2048, p.out, ctxres, nullptr, 0, nullptr, 0);
        xcd_barrier((unsigned*)(ws + OFF_BAR), (volatile LAS unsigned*)(lds + 131072));
        for (int ri = 0; ri < nrange; ++ri) {
            const int a0 = ri == 0 ? f0 : f1, a1 = ri == 0 ? f1 : R;
            if (ri > 0) {
                row_phase<false, true>(p, l, l, a0, a1, p.out, ctxres, nullptr, 0, 0, nullptr, 0, nullptr, nullptr, p.in[8] + l * DM, 3072, HN2, a0);
                xcd_barrier((unsigned*)(ws + OFF_BAR), (volatile LAS unsigned*)(lds + 131072));
            }
            { pg8::Gemm g{HN2, WUP, a1 - a0, NUP, DM, DM}; pg8::StaticOrder S; S.init(a1 - a0, NUP, G, c, WGM_UP); pg8::EpiStore E{GV + (size_t)(a0 - rs) * NUP, NUP}; pg8::gemm_phase(lds, g, S, E); }
            xcd_barrier((unsigned*)(ws + OFF_BAR), (volatile LAS unsigned*)(lds + 131072));
        }
        gate_phase(p, l, rs, rs);
        xcd_barrier((unsigned*)(ws + OFF_BAR), (volatile LAS unsigned*)(lds + 131072));
        { pg8::Gemm g{GV + DFF, WDN, R - rs, DM, DFF, NUP}; pg8::StaticOrder S; S.init(R - rs, DM, G, c, WGM_DN); pg8::EpiStore E{GV, NUP}; pg8::gemm_phase(lds, g, S, E); }
        xcd_barrier((unsigned*)(ws + OFF_BAR), (volatile LAS unsigned*)(lds + 131072));
        if (l == 0) {
            convert_weights(lds, p, 1);
            row_phase<true, false>(p, 0, 0, 0, R, p.out, ctxres, GV, NUP, 0, p.in[9], 5120, p.out, ctxres, nullptr, 0, nullptr, 0);
            xcd_barrier((unsigned*)(ws + OFF_BAR), (volatile LAS unsigned*)(lds + 131072));
            row_phase<false, true>(p, 1, 1, 0, R, p.out, ctxres, nullptr, 0, 0, nullptr, 0, nullptr, nullptr, p.in[6] + DM, 0, HN, 0);
            xcd_barrier((unsigned*)(ws + OFF_BAR), (volatile LAS unsigned*)(lds + 131072));
        } else {
            row_phase<true, false>(p, 1, 1, RC, R, p.out, ctxres, GV, NUP, RC, p.in[9] + DM, 5120, p.out, ctxres, nullptr, 0, nullptr, 0);
        }
    }
}

extern "C" void kernel_launch(void* const* d_in, const int* in_sizes, int n_in, void* d_out, int out_size, void* d_ws, size_t ws_size, hipStream_t stream) {
    static int grid_blocks = 0;
    if (grid_blocks == 0) {
        if (n_in != 33 || ws_size < WS_NEED) { fprintf(stderr, "kernel_launch: unexpected n_in %d or ws_size %zu (< %zu)\n", n_in, ws_size, (size_t)WS_NEED); grid_blocks = -1; return; }
        int dev = 0, cus = 0, per_cu = 0;
        hipGetDevice(&dev);
        hipDeviceGetAttribute(&cus, hipDeviceAttributeMultiprocessorCount, dev);
        hipFuncSetAttribute((const void*)fwd_megakernel, hipFuncAttributeMaxDynamicSharedMemorySize, LDS_BYTES);
        hipOccupancyMaxActiveBlocksPerMultiprocessor(&per_cu, (const void*)fwd_megakernel, 512, LDS_BYTES);
        if (per_cu < 1) { fprintf(stderr, "kernel_launch: occupancy query says %d blocks per CU\n", per_cu); per_cu = 1; }
        grid_blocks = cus * 1;
        fprintf(stderr, "kernel_launch: cus %d per_cu %d grid %d ws %zu\n", cus, per_cu, grid_blocks, ws_size);
    }
    if (grid_blocks < 0) return;
    P p{};
    for (int i = 0; i < 33; ++i) p.in[i] = (const float*)d_in[i];
    p.out = (float*)d_out; p.ws = (unsigned char*)d_ws;
    hipMemsetAsync((unsigned char*)d_ws + OFF_BAR, 0, XCD_BAR_WORDS * 4, stream);
    void* args[] = {&p};
    hipError_t e = hipLaunchCooperativeKernel((const void*)fwd_megakernel, dim3(grid_blocks), dim3(512), args, LDS_BYTES, stream);
    if (e != hipSuccess) fprintf(stderr, "cooperative launch failed: %s (grid %d)\n", hipGetErrorString(e), grid_blocks);
}
```

```cpp
#include <hip/hip_runtime.h>
#include <hip/hip_cooperative_groups.h>
#include <cstdio>
#include <cstdint>
namespace cg = cooperative_groups;

#define LAS __attribute__((address_space(3)))
typedef unsigned short bf16_t;
typedef short bf16x8 __attribute__((ext_vector_type(8)));
typedef float f32x4 __attribute__((ext_vector_type(4)));
typedef unsigned u32x4 __attribute__((ext_vector_type(4)));
typedef unsigned u32x2 __attribute__((ext_vector_type(2)));
typedef float f32x2 __attribute__((ext_vector_type(2)));

constexpr int DM = 1024, NB = 16, SEQ = 2048, CTX = 256;
constexpr int RC = NB * CTX, RL = NB * SEQ, R = RC + RL;
constexpr int NIN = 3584;
constexpr int PMW = 1536, PRW = 2048;
constexpr int DFF = 2816, NUP = 5632;
constexpr int RCOLS = 1952;
constexpr float EPS = 1e-6f;

constexpr size_t MiB = 1u << 20;
constexpr size_t OFF_MOD = 0, OFF_LORA = 1 * MiB, OFF_WIN = 2 * MiB, OFF_WOUT = 9 * MiB, OFF_WUP = 11 * MiB, OFF_WDN = 22 * MiB;
constexpr size_t OFF_CTX = 28 * MiB, OFF_DT = 44 * MiB, OFF_BIG = 47 * MiB;
constexpr size_t OFF_PR = OFF_BIG, OFF_Y = 191 * MiB, OFF_HN = 263 * MiB, OFF_PM = 335 * MiB;
constexpr size_t OFF_D4 = 263 * MiB, OFF_G = 407 * MiB, OFF_MRAW = 263 * MiB;
constexpr size_t OFF_GV = OFF_BIG, OFF_HN2 = 443 * MiB, WS_NEED = 507 * MiB;
constexpr size_t OFF_BAR = 900 * 1024;
#ifndef WGM_IN
#define WGM_IN 4
#endif
#ifndef WGM_OUT
#define WGM_OUT 4
#endif
#ifndef WGM_UP
#define WGM_UP 4
#endif
#ifndef WGM_DN
#define WGM_DN 4
#endif
constexpr int LDS_BYTES = 131072 + 256;

struct P { const float* in[33]; float* out; unsigned char* ws; };

typedef __bf16 bf16x2_t __attribute__((ext_vector_type(2)));
__device__ __forceinline__ unsigned cvt_pk_bf16(float lo, float hi) { const f32x2 v = {lo, hi}; const bf16x2_t b = __builtin_convertvector(v, bf16x2_t); return __builtin_bit_cast(unsigned, b); }
__device__ __forceinline__ float bflo(unsigned u) { return __uint_as_float(u << 16); }
__device__ __forceinline__ float bfhi(unsigned u) { return __uint_as_float(u & 0xffff0000u); }
__device__ __forceinline__ float bfe(const u32x4& v, int e) { unsigned w = v[e >> 1]; return (e & 1) ? bfhi(w) : bflo(w); }
__device__ __forceinline__ float bfe2(const u32x2& v, int e) { unsigned w = v[e >> 1]; return (e & 1) ? bfhi(w) : bflo(w); }
__device__ __forceinline__ float sigmoidf_(float x) { return __builtin_amdgcn_rcpf(1.f + __expf(-x)); }
__device__ __forceinline__ float siluf_(float x) { return x * __builtin_amdgcn_rcpf(1.f + __expf(-x)); }
__device__ __forceinline__ float tanhf_(float x) { return 1.f - 2.f * __builtin_amdgcn_rcpf(__expf(2.f * x) + 1.f); }
#define LDS_BARRIER() do { asm volatile("s_waitcnt lgkmcnt(0)" ::: "memory"); __builtin_amdgcn_s_barrier(); asm volatile("" ::: "memory"); } while (0)
__device__ __forceinline__ int opq_tid() { int t = threadIdx.x; asm volatile("" : "+v"(t)); return t; }
__device__ __forceinline__ int opq_bid() { int t = blockIdx.x; asm volatile("" : "+s"(t)); return t; }
__device__ __forceinline__ float wave_sum(float v) {
#pragma unroll
    for (int o = 1; o < 64; o <<= 1) v += __shfl_xor(v, o);
    return v;
}
#define DPP_ADD(v, ctrl) ((v) + __int_as_float(__builtin_amdgcn_update_dpp(0, __float_as_int(v), (ctrl), 0xf, 0xf, true)))
__device__ __forceinline__ float red8(float v) { v = DPP_ADD(v, 0xB1); v = DPP_ADD(v, 0x4E); v = DPP_ADD(v, 0x141); return v; }
__device__ __forceinline__ float red16(float v) { v = red8(v); v = DPP_ADD(v, 0x140); return v; }
__device__ __forceinline__ void grid_bar(unsigned* bar, unsigned& epoch, unsigned G) {
    asm volatile("s_waitcnt vmcnt(0)" ::: "memory");
    __syncthreads();
    ++epoch;
    if (threadIdx.x == 0) {
        __threadfence();
        asm volatile("s_waitcnt vmcnt(0)" ::: "memory");
        const unsigned old = __hip_atomic_fetch_add(bar, 1u, __ATOMIC_RELAXED, __HIP_MEMORY_SCOPE_AGENT);
        if (old + 1u == epoch * G) __hip_atomic_store(bar + 64, epoch, __ATOMIC_RELAXED, __HIP_MEMORY_SCOPE_AGENT);
        else while (__hip_atomic_load(bar + 64, __ATOMIC_RELAXED, __HIP_MEMORY_SCOPE_AGENT) < epoch) __builtin_amdgcn_s_sleep(1);
        __threadfence();
        asm volatile("s_waitcnt vmcnt(0)" ::: "memory");
    }
    __syncthreads();
}
#define XB_TMO      128
#define XB_XCNT(j)  (256  + 64 * (j))
#define XB_XSUB(j)  (1280 + 64 * (j))
#define XB_XGEN(j)  (2304 + 64 * (j))
#define XB_TOP      3328
#define XB_TOPGEN   3392
#define XCD_BAR_WORDS 3456
#define XB_SPIN_CAP (1u << 18)
__device__ __forceinline__ unsigned xb_ld(unsigned* p)              { return __hip_atomic_load(p, __ATOMIC_RELAXED, __HIP_MEMORY_SCOPE_AGENT); }
__device__ __forceinline__ unsigned xb_add(unsigned* p, unsigned v) { return __hip_atomic_fetch_add(p, v, __ATOMIC_RELAXED, __HIP_MEMORY_SCOPE_AGENT); }
__device__ __forceinline__ unsigned xb_xcc_id() { return (unsigned)__builtin_amdgcn_s_getreg((3 << 11) | 20) & 0xFu; }
#define XB_SPIN(cond, bar) do { unsigned _sp = 0; while (cond) { __builtin_amdgcn_s_sleep(1); \
    if ((++_sp & 255u) == 0u) { if (xb_ld(&(bar)[XB_TMO])) break; if (_sp > XB_SPIN_CAP) { atomicAdd(&(bar)[XB_TMO], 1u); break; } } } } while (0)
struct XcdBarrier { unsigned* bar; unsigned x; volatile LAS unsigned* st; };
__device__ __forceinline__ XcdBarrier xcd_barrier_post(unsigned* bar, volatile LAS unsigned* st) {
    XcdBarrier b; b.bar = bar; b.x = xb_xcc_id(); b.st = st;
    if (threadIdx.x == 0) (void)xb_add(&bar[XB_XCNT(b.x)], 1u);
    return b;
}
__device__ __forceinline__ void xcd_barrier_complete(unsigned* bar, unsigned x, unsigned& nloc, unsigned& nx) {
    const unsigned G = gridDim.x * gridDim.y * gridDim.z;
    unsigned sum, cnt, mine, sp = 0u;
    for (;;) {
        sum = 0u; cnt = 0u; mine = 0u;
#pragma unroll
        for (unsigned j = 0; j < 16; ++j) { const unsigned c = xb_ld(&bar[XB_XCNT(j)]); sum += c; cnt += (c > 0u) ? 1u : 0u; mine = (j == x) ? c : mine; }
        if (sum == G) break;
        __builtin_amdgcn_s_sleep(1);
        if ((++sp & 255u) == 0u) { if (xb_ld(&bar[XB_TMO])) break; if (sp > XB_SPIN_CAP) { atomicAdd(&bar[XB_TMO], 1u); break; } }
    }
    nloc = mine > 0u ? mine : 1u; nx = cnt > 0u ? cnt : 1u;
}
__device__ __forceinline__ void xcd_barrier(unsigned* bar_, volatile LAS unsigned* st_) {
    XcdBarrier b; b.bar = bar_; b.st = st_; b.x = 0u;
    asm volatile("s_waitcnt vmcnt(0)" ::: "memory");
    __syncthreads();
    if (threadIdx.x == 0) {
        unsigned* bar = b.bar; b.x = xb_xcc_id();
        __builtin_amdgcn_s_waitcnt(0);
        unsigned nloc = b.st[0], nx = b.st[1];
        if (nloc == 0u) { xcd_barrier_complete(bar, b.x, nloc, nx); b.st[0] = nloc; b.st[1] = nx; }
        const unsigned old = xb_add(&bar[XB_XSUB(b.x)], 1u);
        const unsigned gen = old / nloc;
        if (old + 1u == (gen + 1u) * nloc) {
            __builtin_amdgcn_fence(__ATOMIC_RELEASE, "agent");
            asm volatile("s_waitcnt vmcnt(0)" ::: "memory");
            const unsigned og = xb_add(&bar[XB_TOP], 1u);
            const unsigned tg = og / nx;
            if (og + 1u == (tg + 1u) * nx) xb_add(&bar[XB_TOPGEN], 1u);
            else XB_SPIN(xb_ld(&bar[XB_TOPGEN]) == tg, bar);
            __builtin_amdgcn_fence(__ATOMIC_ACQUIRE, "agent");
            xb_add(&bar[XB_XGEN(b.x)], 1u);
            asm volatile("s_waitcnt vmcnt(0)" ::: "memory");
        } else {
            XB_SPIN(xb_ld(&bar[XB_XGEN(b.x)]) == gen, bar);
            __builtin_amdgcn_fence(__ATOMIC_ACQUIRE, "agent");
            asm volatile("s_waitcnt vmcnt(0)" ::: "memory");
        }
    }
    __syncthreads();
}
__device__ __forceinline__ void row_info(int row, int& first, int& last, int& mrow) {
    if (row < RC) { int t = row & (CTX - 1); first = (t == 0); last = (t == CTX - 1); mrow = 16; }
    else { int rr = row - RC; int t = rr & (SEQ - 1); first = (t == 0); last = (t == SEQ - 1); mrow = rr >> 11; }
}
__device__ __forceinline__ void seqpos(int s, int dir, int b, int& row, int& first, int& last) {
    if (s < CTX) { int t = dir ? (CTX - 1 - s) : s; row = b * CTX + t; first = (t == 0); last = (t == CTX - 1); }
    else { int u = s - CTX; int t = dir ? (SEQ - 1 - u) : u; row = RC + b * SEQ + t; first = (t == 0); last = (t == SEQ - 1); }
}

namespace pg8 {
constexpr int BM = 256, BK = 64, HALF = 128, HTB = HALF * BK * 2, NXCD = 8;
__device__ __forceinline__ int lds_byte(int r, int c) { const int st = (r >> 4) * 2 + (c >> 5), rr = r & 15, cc = c & 31, ob = rr * 64 + cc * 2; return st * 1024 + (ob ^ (((ob >> 9) & 1) << 5)); }
__device__ __forceinline__ void stage_rc(int b, int& Rr, int& C) { const int st = b / 1024, sb = b % 1024, swz = sb ^ (((sb >> 9) & 1) << 5); Rr = (st >> 1) * 16 + swz / 64; C = (st & 1) * 32 + (swz % 64) / 2; }
__device__ __forceinline__ int perm32(int rho) { const int n = rho >> 4, i = rho & 15; return 8 * (i >> 2) + 4 * n + (i & 3); }
struct Unit { int pm, pn; };
struct Gemm { const bf16_t* A; const bf16_t* Bt; int M, N, K, lda; };
struct StaticOrder {
    int nM, nN, nwg, G, c, WGM;
    __device__ void init(int M, int N, int G_, int c_, int wgm_) { nM = M / BM; nN = N / BM; nwg = nM * nN; G = G_; c = c_; WGM = wgm_; }
    __device__ bool next(int i, Unit& u) const {
        const long L = (long)i * G + c; if (L >= nwg) return false;
        int wgid = (int)L; { const int q = nwg / NXCD, r = nwg % NXCD, xcd = wgid % NXCD, off = wgid / NXCD; wgid = (xcd < r ? xcd * (q + 1) : r * (q + 1) + (xcd - r) * q) + off; }
        const int nig = WGM * nN, gid = wgid / nig, fm = gid * WGM, gsz = (nM - fm) < WGM ? (nM - fm) : WGM;
        u.pm = fm + ((wgid % nig) % gsz); u.pn = (wgid % nig) / gsz; return true;
    }
};
struct EpiStore {
    bf16_t* O; int ldc;
    __device__ __forceinline__ void operator()(const f32x4 (&acc)[2][2][4][2], const Unit& u, int wr, int wc, int fr, int fq) const {
        const int row0 = u.pm * BM + wr * 64 + fr, col0 = u.pn * BM + wc * 32 + 8 * fq;
#pragma unroll
        for (int ai = 0; ai < 2; ++ai)
#pragma unroll
            for (int m = 0; m < 4; ++m) { bf16_t* rowp = O + (size_t)(row0 + ai * HALF + m * 16) * ldc + col0;
#pragma unroll
                for (int bj = 0; bj < 2; ++bj) { const f32x4 v0 = acc[ai][bj][m][0], v1 = acc[ai][bj][m][1];
                    u32x4 w; w.x = cvt_pk_bf16(v0[0], v0[1]); w.y = cvt_pk_bf16(v0[2], v0[3]); w.z = cvt_pk_bf16(v1[0], v1[1]); w.w = cvt_pk_bf16(v1[2], v1[3]);
                    *(u32x4*)(rowp + bj * HALF) = w; } }
    }
};
struct EpiInProj {
    bf16_t* PM; bf16_t* PR; float* DT;
    __device__ __forceinline__ void operator()(const f32x4 (&acc)[2][2][4][2], const Unit& u, int wr, int wc, int fr, int fq) const {
        const int row0 = u.pm * BM + wr * 64 + fr;
        bf16_t* base; int ldc, colt;
        if (u.pn < 6) { base = PM; ldc = PMW; colt = u.pn * BM; } else { base = PR; ldc = PRW; colt = (u.pn - 6) * BM; }
        const int col0 = colt + wc * 32 + 8 * fq;
        const bool isdt = (u.pn == 13) && (wc == 1) && (fq < 2);
#pragma unroll
        for (int ai = 0; ai < 2; ++ai)
#pragma unroll
            for (int m = 0; m < 4; ++m) { const int row = row0 + ai * HALF + m * 16; bf16_t* rowp = base + (size_t)row * ldc + col0;
#pragma unroll
                for (int bj = 0; bj < 2; ++bj) { const f32x4 v0 = acc[ai][bj][m][0], v1 = acc[ai][bj][m][1];
                    u32x4 w; w.x = cvt_pk_bf16(v0[0], v0[1]); w.y = cvt_pk_bf16(v0[2], v0[3]); w.z = cvt_pk_bf16(v1[0], v1[1]); w.w = cvt_pk_bf16(v1[2], v1[3]);
                    *(u32x4*)(rowp + bj * HALF) = w; }
                if (isdt) { float* d = DT + (size_t)row * 16 + fq * 8; *(f32x4*)d = acc[ai][1][m][0]; *(f32x4*)(d + 4) = acc[ai][1][m][1]; } }
    }
};

template <class Epi>
__device__ __forceinline__ void gemm_phase(LAS unsigned char* lds, const Gemm g, const StaticOrder& S, const Epi& E) {
    const int tid = opq_tid(), wid = __builtin_amdgcn_readfirstlane(tid >> 6), lane = tid & 63, wr = wid >> 2, wc = wid & 3, fr = lane & 15, fq = lane >> 4;
    const int K = g.K, nt = K / BK, lda = g.lda;
    unsigned voffA[2], voffB[2];
#pragma unroll
    for (int i = 0; i < 2; ++i) { int Rr, C; stage_rc(tid * 16 + i * 8192, Rr, C); const int Rb = (Rr & ~31) + perm32(Rr & 31);
        voffA[i] = (unsigned)(Rr * lda + C) * 2u; voffB[i] = (unsigned)(Rb * K + C) * 2u; }
    const size_t kstep = (size_t)(BK * 2);
    const size_t hsA = (size_t)HALF * lda * 2, hsB = (size_t)HALF * K * 2;
    const size_t tsA = 2 * hsA, tsB = 2 * hsB;
    const unsigned ldsw = (unsigned)wid * 1024u;
    const int aoff = lds_byte(wr * 64 + fr, fq * 8), boff = lds_byte(wc * 32 + fr, fq * 8);
#define PG8_SA(b, h) (((b) * 2 + (h)) * HTB)
#define PG8_SB(b, h) ((4 + (b) * 2 + (h)) * HTB)
#define PG8_STAGE(bufoff, gbase, voff) do { _Pragma("unroll") for (int _i = 0; _i < 2; ++_i) \
        __builtin_amdgcn_global_load_lds((const unsigned*)((const char*)(gbase) + (voff)[_i]), (LAS unsigned*)(lds + (bufoff) + ldsw + _i * 8192), 16, 0, 0); } while (0)
#define PG8_LDA(dst, b, h) do { _Pragma("unroll") for (int m = 0; m < 4; ++m) _Pragma("unroll") for (int k = 0; k < 2; ++k) dst[m][k] = *(const LAS bf16x8*)(lds + PG8_SA(b, h) + aoff + m * 2048 + k * 1024); } while (0)
#define PG8_LDB(dst, b, h) do { _Pragma("unroll") for (int n = 0; n < 2; ++n) _Pragma("unroll") for (int k = 0; k < 2; ++k) dst[n][k] = *(const LAS bf16x8*)(lds + PG8_SB(b, h) + boff + n * 2048 + k * 1024); } while (0)
#define PG8_MMA(ai, bj, At, Bt) do { __builtin_amdgcn_s_setprio(1); _Pragma("unroll") for (int m = 0; m < 4; ++m) _Pragma("unroll") for (int n = 0; n < 2; ++n) _Pragma("unroll") for (int k = 0; k < 2; ++k) \
        acc[ai][bj][m][n] = __builtin_amdgcn_mfma_f32_16x16x32_bf16(Bt[n][k], At[m][k], acc[ai][bj][m][n], 0, 0, 0); __builtin_amdgcn_s_setprio(0); } while (0)
#define PG8_WAIT_V(n) asm volatile("s_waitcnt vmcnt(" #n ")" ::: "memory")
#define PG8_WAIT_L(n) asm volatile("s_waitcnt lgkmcnt(" #n ")" ::: "memory")
#define PG8_BAR __builtin_amdgcn_s_barrier()
#define PG8_SCHED __builtin_amdgcn_sched_barrier(0)
    Unit cur, nxt; int ui = 0;
    if (!S.next(0, cur)) return;
    f32x4 acc[2][2][4][2];
#pragma unroll
    for (int a = 0; a < 2; ++a)
#pragma unroll
        for (int b = 0; b < 2; ++b)
#pragma unroll
            for (int m = 0; m < 4; ++m)
#pragma unroll
                for (int n = 0; n < 2; ++n) acc[a][b][m][n] = (f32x4){0.f, 0.f, 0.f, 0.f};
    bf16x8 At[4][2], B0[2][2], B1[2][2];
    const char* cA = (const char*)g.A + (size_t)cur.pm * tsA; const char* cB = (const char*)g.Bt + (size_t)cur.pn * tsB;
    PG8_STAGE(PG8_SB(0, 0), cB, voffB); PG8_STAGE(PG8_SB(0, 1), cB + hsB, voffB); PG8_STAGE(PG8_SA(0, 0), cA, voffA); PG8_STAGE(PG8_SA(0, 1), cA + hsA, voffA);
    if (wr == 1) PG8_BAR;
    PG8_WAIT_V(2); PG8_BAR;
    PG8_STAGE(PG8_SB(1, 0), cB + kstep, voffB); PG8_STAGE(PG8_SA(1, 0), cA + kstep, voffA); PG8_STAGE(PG8_SB(1, 1), cB + hsB + kstep, voffB);
    PG8_WAIT_V(6); PG8_BAR;
    for (;;) {
        const bool has_next = S.next(ui + 1, nxt);
        const char* nA = has_next ? (const char*)g.A + (size_t)nxt.pm * tsA : cA; const char* nB = has_next ? (const char*)g.Bt + (size_t)nxt.pn * tsB : cB;
        for (int t = 0; t < nt; t += 2) {
            const bool last = (t == nt - 2);
            const char* a1 = cA + (size_t)(t + 1) * kstep;
            const char* a2 = last ? nA : cA + (size_t)(t + 2) * kstep; const char* b2 = last ? nB : cB + (size_t)(t + 2) * kstep;
            const char* a3 = a2 + kstep; const char* b3 = b2 + kstep;
            PG8_LDB(B0, 0, 0); PG8_LDB(B1, 0, 1); PG8_SCHED; PG8_LDA(At, 0, 0); PG8_STAGE(PG8_SA(1, 1), a1 + hsA, voffA);
            PG8_WAIT_V(8); PG8_WAIT_L(0); PG8_BAR; PG8_MMA(0, 0, At, B0); PG8_MMA(0, 1, At, B1); PG8_BAR; PG8_SCHED;
            PG8_LDA(At, 0, 1); PG8_STAGE(PG8_SB(0, 0), b2, voffB); PG8_STAGE(PG8_SB(0, 1), b2 + hsB, voffB); PG8_STAGE(PG8_SA(0, 0), a2, voffA);
            PG8_WAIT_V(8); PG8_WAIT_L(0); PG8_BAR; PG8_MMA(1, 0, At, B0); PG8_MMA(1, 1, At, B1); PG8_BAR; PG8_SCHED;
            PG8_LDB(B0, 1, 0); PG8_LDB(B1, 1, 1); PG8_SCHED; PG8_LDA(At, 1, 0); PG8_STAGE(PG8_SA(0, 1), a2 + hsA, voffA);
            PG8_WAIT_V(8); PG8_WAIT_L(0); PG8_BAR; PG8_MMA(0, 0, At, B0); PG8_MMA(0, 1, At, B1); PG8_BAR; PG8_SCHED;
            PG8_LDA(At, 1, 1); PG8_STAGE(PG8_SB(1, 0), b3, voffB); PG8_STAGE(PG8_SB(1, 1), b3 + hsB, voffB); PG8_STAGE(PG8_SA(1, 0), a3, voffA);
            PG8_WAIT_V(8); PG8_WAIT_L(0); PG8_BAR; PG8_MMA(1, 0, At, B0); PG8_MMA(1, 1, At, B1); PG8_BAR; PG8_SCHED;
        }
        if (wr == 0) PG8_BAR;
        E(acc, cur, wr, wc, fr, fq);
        if (!has_next) break;
#pragma unroll
        for (int a = 0; a < 2; ++a)
#pragma unroll
            for (int b = 0; b < 2; ++b)
#pragma unroll
                for (int m = 0; m < 4; ++m)
#pragma unroll
                    for (int n = 0; n < 2; ++n) acc[a][b][m][n] = (f32x4){0.f, 0.f, 0.f, 0.f};
        cur = nxt; cA = nA; cB = nB; ++ui;
        if (wr == 1) PG8_BAR;
    }
    PG8_WAIT_V(0);
    PG8_BAR;
#undef PG8_SA
#undef PG8_SB
#undef PG8_STAGE
#undef PG8_LDA
#undef PG8_LDB
#undef PG8_MMA
#undef PG8_WAIT_V
#undef PG8_WAIT_L
#undef PG8_BAR
#undef PG8_SCHED
}
}

__device__ __forceinline__ int win_colmap(int j) { return j < 1536 ? j : (j < 3488 ? j + 16 : (j < 3504 ? j - 1952 : -1)); }
template <bool WIN>
__device__ __forceinline__ void transpose_tile(LAS float* tile, const float* W, int K, int N, bf16_t* WT, int item, int ntn) {
    const int tid = opq_tid(), n0 = (item % ntn) * 64, k0 = (item / ntn) * 64;
    const int tx = tid & 63, ty = tid >> 6;
    int col = n0 + tx; if (WIN) col = win_colmap(col);
#pragma unroll
    for (int i = 0; i < 8; ++i) { const int kk = ty + i * 8; tile[kk * 65 + tx] = (col >= 0) ? W[(size_t)(k0 + kk) * N + col] : 0.f; }
    __syncthreads();
    const int n = tid >> 3, ks = (tid & 7) * 8;
    u32x4 o; o.x = cvt_pk_bf16(tile[(ks + 0) * 65 + n], tile[(ks + 1) * 65 + n]); o.y = cvt_pk_bf16(tile[(ks + 2) * 65 + n], tile[(ks + 3) * 65 + n]);
    o.z = cvt_pk_bf16(tile[(ks + 4) * 65 + n], tile[(ks + 5) * 65 + n]); o.w = cvt_pk_bf16(tile[(ks + 6) * 65 + n], tile[(ks + 7) * 65 + n]);
    *(u32x4*)(WT + (size_t)(n0 + n) * K + k0 + ks) = o;
    __syncthreads();
}
__device__ __forceinline__ void convert_weights(LAS unsigned char* lds, const P& p, int l) {
    LAS float* tile = (LAS float*)lds;
    unsigned char* ws = p.ws;
    constexpr int I_IN = (NIN / 64) * (DM / 64), I_OUT = 16 * 16, I_UP = (NUP / 64) * 16, I_DN = 16 * (DFF / 64);
    for (int it = opq_bid(); it < I_IN + I_OUT + I_UP + I_DN; it += gridDim.x) {
        int r = it;
        if (r < I_IN) { transpose_tile<true>(tile, p.in[10] + (size_t)l * DM * 3504, DM, 3504, (bf16_t*)(ws + OFF_WIN), r, NIN / 64); continue; } r -= I_IN;
        if (r < I_OUT) { transpose_tile<false>(tile, p.in[11] + (size_t)l * DM * DM, DM, DM, (bf16_t*)(ws + OFF_WOUT), r, 16); continue; } r -= I_OUT;
        if (r < I_UP) { transpose_tile<false>(tile, p.in[29] + (size_t)l * DM * NUP, DM, NUP, (bf16_t*)(ws + OFF_WUP), r, NUP / 64); continue; } r -= I_UP;
        transpose_tile<false>(tile, p.in[32] + (size_t)l * DFF * DM, DFF, DM, (bf16_t*)(ws + OFF_WDN), r, 16);
    }
    bf16_t* W2t = (bf16_t*)(ws + OFF_LORA); bf16_t* A2t = W2t + 2 * 512 * 64; bf16_t* G2t = A2t + 2 * 512 * 64;
    const int gt = opq_bid() * 512 + opq_tid(), gs = gridDim.x * 512;
    for (int i = gt; i < 2 * 512 * 64; i += gs) { const int d = i >> 15, n = (i >> 6) & 511, k = i & 63;
        W2t[i] = (bf16_t)(cvt_pk_bf16(p.in[20][((size_t)(l * 2 + d) * 64 + k) * 512 + n], 0.f) & 0xffffu);
        A2t[i] = (bf16_t)(cvt_pk_bf16(p.in[22][((size_t)(l * 2 + d) * 64 + k) * 512 + n], 0.f) & 0xffffu); }
    for (int i = gt; i < 512 * 160; i += gs) { const int n = i / 160, k = i % 160;
        G2t[i] = (bf16_t)(cvt_pk_bf16(p.in[23][((size_t)l * 160 + k) * 512 + n], 0.f) & 0xffffu); }
}

__device__ __forceinline__ void mod_phase(LAS unsigned char* lds, const P& p) {
    LAS float* sil = (LAS float*)lds;
    LAS float* red = sil + 17 * 1024;
    const int tid = opq_tid();
    float* mod = (float*)(p.ws + OFF_MOD);
    if ((int)opq_bid() >= 384) return;
    __syncthreads();
    for (int i = tid; i < 17 * 1024; i += 512) { const int r = i >> 10, k = i & 1023; const float v = (r < 16) ? p.in[1][r * 1024 + k] : p.in[3][k]; sil[i] = siluf_(v); }
    __syncthreads();
    for (int item = opq_bid(); item < 384; item += gridDim.x) {
        const int l = item / 192, cb = item % 192, cc = tid & 31, kg = tid >> 5, col = cb * 32 + cc;
        float acc[17];
#pragma unroll
        for (int r = 0; r < 17; ++r) acc[r] = 0.f;
        const float* wp = p.in[4] + ((size_t)l * 1024 + kg * 64) * 6144 + col;
#pragma unroll 4
        for (int kk = 0; kk < 64; ++kk) { const float w = wp[(size_t)kk * 6144]; const int k = kg * 64 + kk;
#pragma unroll
            for (int r = 0; r < 17; ++r) acc[r] += sil[r * 1024 + k] * w; }
#pragma unroll
        for (int r = 0; r < 17; ++r) red[(kg * 17 + r) * 32 + cc] = acc[r];
        __syncthreads();
        for (int idx = tid; idx < 17 * 32; idx += 512) { const int r = idx >> 5, c2 = idx & 31; float s = p.in[5][l * 6144 + cb * 32 + c2];
            for (int k2 = 0; k2 < 16; ++k2) s += red[(k2 * 17 + r) * 32 + c2];
            mod[(size_t)(l * 17 + r) * 6144 + cb * 32 + c2] = s; }
        __syncthreads();
    }
}

template <bool POST, bool NORM>
__device__ __forceinline__ void row_phase(const P& p, int l, int lN, int r0, int r1,
                                          const float* xlat, const float* xctx,
                                          const bf16_t* M, int ldm, int mbase,
                                          const float* gpost, int gateoff,
                                          float* olat, float* octx,
                                          const float* gpre, int shoff,
                                          bf16_t* HN, int hbase) {
    const int lane = opq_tid() & 63, wid = opq_tid() >> 6;
    const float* mod = (const float*)(p.ws + OFF_MOD);
    const int npair = (r1 - r0) >> 1, pend = npair, pstep = (int)gridDim.x * 8;
    f32x4 gt[4], sh[4], sc[4];
    int curm = -1;
    f32x4 xA[2][4], xB[2][4]; u32x2 mA[2][4], mB[2][4];
#define RP_LOAD(X, pr_) do { const int rowb_ = r0 + (pr_) * 2; const bool isc_ = rowb_ < RC; \
        const float* xr_ = isc_ ? xctx + (size_t)rowb_ * DM : xlat + (size_t)(rowb_ - RC) * DM; \
        _Pragma("unroll") for (int u = 0; u < 2; ++u) _Pragma("unroll") for (int i = 0; i < 4; ++i) x##X[u][i] = *(const f32x4*)(xr_ + u * DM + i * 256 + lane * 4); \
        if (POST) { const bf16_t* mr_ = M + (size_t)(rowb_ - mbase) * ldm; \
            _Pragma("unroll") for (int u = 0; u < 2; ++u) _Pragma("unroll") for (int i = 0; i < 4; ++i) m##X[u][i] = *(const u32x2*)(mr_ + (size_t)u * ldm + i * 256 + lane * 4); } } while (0)
#define RP_COMPUTE(X, pr_) do { const int rowb = r0 + (pr_) * 2; const bool isc = rowb < RC; const int mrow = isc ? 16 : ((rowb - RC) >> 11); \
        if (mrow != curm) { curm = mrow; \
            _Pragma("unroll") for (int i = 0; i < 4; ++i) { const int c = i * 256 + lane * 4; \
                if (POST) gt[i] = *(const f32x4*)(mod + (size_t)(l * 17 + mrow) * 6144 + gateoff + c); \
                if (NORM) { sh[i] = *(const f32x4*)(mod + (size_t)(lN * 17 + mrow) * 6144 + shoff + c); sc[i] = *(const f32x4*)(mod + (size_t)(lN * 17 + mrow) * 6144 + shoff + 1024 + c); } } } \
        if (POST) { float ss0 = 0.f, ss1 = 0.f; f32x4 mv[2][4]; \
            _Pragma("unroll") for (int i = 0; i < 4; ++i) { \
                const u32x2 w0 = m##X[0][i], w1 = m##X[1][i]; \
                mv[0][i] = (f32x4){bflo(w0.x), bfhi(w0.x), bflo(w0.y), bfhi(w0.y)}; mv[1][i] = (f32x4){bflo(w1.x), bfhi(w1.x), bflo(w1.y), bfhi(w1.y)}; \
                ss0 += mv[0][i][0] * mv[0][i][0] + mv[0][i][1] * mv[0][i][1] + mv[0][i][2] * mv[0][i][2] + mv[0][i][3] * mv[0][i][3]; \
                ss1 += mv[1][i][0] * mv[1][i][0] + mv[1][i][1] * mv[1][i][1] + mv[1][i][2] * mv[1][i][2] + mv[1][i][3] * mv[1][i][3]; } \
            const float rs0 = rsqrtf(wave_sum(ss0) * (1.f / DM) + EPS), rs1 = rsqrtf(wave_sum(ss1) * (1.f / DM) + EPS); \
            float* orow = isc ? octx + (size_t)rowb * DM : olat + (size_t)(rowb - RC) * DM; \
            _Pragma("unroll") for (int i = 0; i < 4; ++i) { const int c = i * 256 + lane * 4; \
                const f32x4 gpi = *(const f32x4*)(gpost + c); \
                x##X[0][i] = x##X[0][i] + gt[i] * (mv[0][i] * rs0 * gpi); x##X[1][i] = x##X[1][i] + gt[i] * (mv[1][i] * rs1 * gpi); \
                *(f32x4*)(orow + c) = x##X[0][i]; *(f32x4*)(orow + DM + c) = x##X[1][i]; } } \
        if (NORM) { float ss0 = 0.f, ss1 = 0.f; \
            _Pragma("unroll") for (int i = 0; i < 4; ++i) { \
                ss0 += x##X[0][i][0] * x##X[0][i][0] + x##X[0][i][1] * x##X[0][i][1] + x##X[0][i][2] * x##X[0][i][2] + x##X[0][i][3] * x##X[0][i][3]; \
                ss1 += x##X[1][i][0] * x##X[1][i][0] + x##X[1][i][1] * x##X[1][i][1] + x##X[1][i][2] * x##X[1][i][2] + x##X[1][i][3] * x##X[1][i][3]; } \
            const float rs0 = rsqrtf(wave_sum(ss0) * (1.f / DM) + EPS), rs1 = rsqrtf(wave_sum(ss1) * (1.f / DM) + EPS); \
            bf16_t* hr = HN + (size_t)(rowb - hbase) * DM; \
            _Pragma("unroll") for (int i = 0; i < 4; ++i) { const int c = i * 256 + lane * 4; \
                const f32x4 g4i = *(const f32x4*)(gpre + c); \
                const f32x4 y0 = (x##X[0][i] * rs0 * g4i) * (sc[i] + 1.f) + sh[i], y1 = (x##X[1][i] * rs1 * g4i) * (sc[i] + 1.f) + sh[i]; \
                u32x2 o; o.x = cvt_pk_bf16(y0[0], y0[1]); o.y = cvt_pk_bf16(y0[2], y0[3]); *(u32x2*)(hr + c) = o; \
                o.x = cvt_pk_bf16(y1[0], y1[1]); o.y = cvt_pk_bf16(y1[2], y1[3]); *(u32x2*)(hr + DM + c) = o; } } } while (0)
    int pr = opq_bid() * 8 + wid;
    if (pr < pend) RP_LOAD(A, pr);
    while (pr < pend) {
        int pn = pr + pstep;
        if (pn < pend) RP_LOAD(B, pn);
        __builtin_amdgcn_sched_barrier(0);
        RP_COMPUTE(A, pr);
        __builtin_amdgcn_sched_barrier(0);
        pr = pn; if (pr >= pend) break;
        pn = pr + pstep;
        if (pn < pend) RP_LOAD(A, pn);
        __builtin_amdgcn_sched_barrier(0);
        RP_COMPUTE(B, pr);
        __builtin_amdgcn_sched_barrier(0);
        pr = pn;
    }
#undef RP_LOAD
#undef RP_COMPUTE
}

__device__ __forceinline__ void xbc_phase(const P& p, int l) {
    const bf16_t* PM = (const bf16_t*)(p.ws + OFF_PM);
    bf16_t* XBC = (bf16_t*)(p.ws + OFF_HN);
    const float* cw = p.in[12] + (size_t)l * 3 * 1024; const float* cb = p.in[13] + (size_t)l * 1024;
    const int idx0 = opq_bid() * 512 + opq_tid(), istep = (int)gridDim.x * 512, c8 = (idx0 & 127) * 8;
    f32x4 w0[2], w1[2], w2[2], bb[2];
#pragma unroll
    for (int hh = 0; hh < 2; ++hh) { w0[hh] = *(const f32x4*)(cw + c8 + hh * 4); w1[hh] = *(const f32x4*)(cw + 1024 + c8 + hh * 4); w2[hh] = *(const f32x4*)(cw + 2048 + c8 + hh * 4); bb[hh] = *(const f32x4*)(cb + c8 + hh * 4); }
    const u32x4 z4 = (u32x4){0u, 0u, 0u, 0u};
    u32x4 xcA, xpA, xnA, xcB, xpB, xnB; int flA = 0, flB = 0;
#define XQ_LOAD(X, idx_) do { const int row_ = (idx_) >> 7; int f_, l_, m_; row_info(row_, f_, l_, m_); const bf16_t* src = PM + (size_t)row_ * PMW + 512 + c8; \
        xc##X = *(const u32x4*)src; xp##X = *(const u32x4*)(src - (f_ ? 0 : PMW)); xn##X = *(const u32x4*)(src + (l_ ? 0 : PMW)); fl##X = f_ | (l_ << 1); } while (0)
#define XQ_COMPUTE(X, idx_) do { float o[8]; const u32x4 xp_ = (fl##X & 1) ? z4 : xp##X, xn_ = (fl##X & 2) ? z4 : xn##X; \
        _Pragma("unroll") for (int hh = 0; hh < 2; ++hh) _Pragma("unroll") for (int e = 0; e < 4; ++e) \
            o[hh * 4 + e] = siluf_(w0[hh][e] * bfe(xp_, hh * 4 + e) + w1[hh][e] * bfe(xc##X, hh * 4 + e) + w2[hh][e] * bfe(xn_, hh * 4 + e) + bb[hh][e]); \
        u32x4 w; w.x = cvt_pk_bf16(o[0], o[1]); w.y = cvt_pk_bf16(o[2], o[3]); w.z = cvt_pk_bf16(o[4], o[5]); w.w = cvt_pk_bf16(o[6], o[7]); \
        *(u32x4*)(XBC + (size_t)((idx_) >> 7) * 1024 + c8) = w; } while (0)
    const int iend = R * 128;
    int idx = idx0;
    if ((istep & 127) != 0) {
        for (; idx < iend; idx += istep) { const int row = idx >> 7, cc = (idx & 127) * 8; int first, last, mrow; row_info(row, first, last, mrow);
            const bf16_t* src = PM + (size_t)row * PMW + 512 + cc;
            const u32x4 xc = *(const u32x4*)src, xp = first ? z4 : *(const u32x4*)(src - PMW), xn = last ? z4 : *(const u32x4*)(src + PMW);
            float o[8];
#pragma unroll
            for (int e = 0; e < 8; ++e) o[e] = siluf_(cw[cc + e] * bfe(xp, e) + cw[1024 + cc + e] * bfe(xc, e) + cw[2048 + cc + e] * bfe(xn, e) + cb[cc + e]);
            u32x4 w; w.x = cvt_pk_bf16(o[0], o[1]); w.y = cvt_pk_bf16(o[2], o[3]); w.z = cvt_pk_bf16(o[4], o[5]); w.w = cvt_pk_bf16(o[6], o[7]);
            *(u32x4*)(XBC + (size_t)row * 1024 + cc) = w; }
        return;
    }
    if (idx < iend) XQ_LOAD(A, idx);
    while (idx < iend) {
        int in_ = idx + istep;
        if (in_ < iend) XQ_LOAD(B, in_);
        __builtin_amdgcn_sched_barrier(0);
        XQ_COMPUTE(A, idx);
        __builtin_amdgcn_sched_barrier(0);
        idx = in_; if (idx >= iend) break;
        in_ = idx + istep;
        if (in_ < iend) XQ_LOAD(A, in_);
        __builtin_amdgcn_sched_barrier(0);
        XQ_COMPUTE(B, idx);
        __builtin_amdgcn_sched_barrier(0);
        idx = in_;
    }
#undef XQ_LOAD
#undef XQ_COMPUTE
}

__device__ __forceinline__ void mamba_chunk_phase(LAS unsigned char* lds, const P& p, int l) {
    constexpr int Q = 64, NCH = (CTX + SEQ) / Q, SX = 72, SB = 136;
    LAS bf16_t* XT = (LAS bf16_t*)lds;
    LAS bf16_t* XsT = XT + 64 * SX;
    LAS bf16_t* Mm = XsT + 64 * SX;
    LAS bf16_t* BT = Mm + 64 * SX;
    LAS bf16_t* Bm = BT + 128 * SX;
    LAS bf16_t* Cm = Bm + 64 * SB;
    LAS bf16_t* Hb = Cm + 64 * SB;
    LAS float* fab = (LAS float*)(Hb + 64 * SB);
    const int tid = opq_tid(), lane = tid & 63, w = tid >> 6, fr = lane & 15, fq = lane >> 4;
    const bf16_t* XBC = (const bf16_t*)(p.ws + OFF_HN);
    const float* DT = (const float*)(p.ws + OFF_DT);
    bf16_t* Y = (bf16_t*)(p.ws + OFF_Y);
    for (int q = opq_bid(); q < 256; q += gridDim.x) {
        const int b = q >> 4, h = (q >> 1) & 7, dir = q & 1, g = h >> 2;
        const float dtb = p.in[14][l * 16 + dir * 8 + h];
        const float Aneg = -expf(p.in[15][l * 16 + dir * 8 + h]);
        f32x4 Hacc[4];
#pragma unroll
        for (int i = 0; i < 4; ++i) Hacc[i] = (f32x4){0.f, 0.f, 0.f, 0.f};
        u32x4 pre[5]; float dtraw = 0.f;
#define C_ISSUE(ci) do { int row, first, last; seqpos((ci) * Q + lane, dir, b, row, first, last); const bf16_t* rp = XBC + (size_t)row * 1024; \
            _Pragma("unroll") for (int i = 0; i < 5; ++i) { const int pc = w + 8 * i; \
                const int col = pc < 8 ? h * 64 + pc * 8 : (pc < 24 ? 512 + g * 128 + (pc - 8) * 8 : 768 + g * 128 + (pc - 24) * 8); \
                pre[i] = *(const u32x4*)(rp + col); } \
            if (tid < Q) dtraw = DT[(size_t)row * 16 + dir * 8 + h]; } while (0)
#define C_STORE() do { const int j = lane; _Pragma("unroll") for (int i = 0; i < 5; ++i) { const int pc = w + 8 * i; const u32x4 v = pre[i]; \
            if (pc < 8) { _Pragma("unroll") for (int e = 0; e < 8; ++e) XT[(pc * 8 + e) * SX + j] = (bf16_t)((e & 1) ? (v[e >> 1] >> 16) : (v[e >> 1] & 0xffffu)); } \
            else if (pc < 24) { const int n0 = (pc - 8) * 8; *(LAS u32x4*)(Bm + j * SB + n0) = v; \
                _Pragma("unroll") for (int e = 0; e < 8; ++e) BT[(n0 + e) * SX + j] = (bf16_t)((e & 1) ? (v[e >> 1] >> 16) : (v[e >> 1] & 0xffffu)); } \
            else { const int n0 = (pc - 24) * 8; *(LAS u32x4*)(Cm + j * SB + n0) = v; } } } while (0)
        __syncthreads();
        for (int i = tid; i < 64 * SB / 2; i += 512) ((LAS unsigned*)Hb)[i] = 0u;
        C_ISSUE(0); C_STORE();
        float dtcur = dtraw;
        if (w == 0) { LAS float* faw = fab;
                const float xx = dtcur + dtb; const float dt = xx > 20.f ? xx : log1pf(__expf(xx));
                float a = dt * Aneg;
                a = DPP_ADD(a, 0x111); a = DPP_ADD(a, 0x112); a = DPP_ADD(a, 0x114); a = DPP_ADD(a, 0x118);
                const float t15 = __int_as_float(__builtin_amdgcn_readlane(__float_as_int(a), 15));
                const float t31 = __int_as_float(__builtin_amdgcn_readlane(__float_as_int(a), 31));
                const float t47 = __int_as_float(__builtin_amdgcn_readlane(__float_as_int(a), 47));
                a += (lane >= 48) ? (t15 + t31 + t47) : (lane >= 32 ? (t15 + t31) : (lane >= 16 ? t15 : 0.f));
                const float cl = __int_as_float(__builtin_amdgcn_readlane(__float_as_int(a), 63));
                faw[lane] = a; faw[64 + lane] = __expf(a); faw[128 + lane] = __expf(cl - a) * dt; faw[192 + lane] = dt;
        }
        __syncthreads();
        for (int ci = 0; ci < NCH; ++ci) {
            if (ci + 1 < NCH) C_ISSUE(ci + 1);
            LAS float* fa = fab + (ci & 1) * 256;
            { const int ti = w >> 1, tj0 = (w & 1) * 2;
              f32x4 gacc[2] = {(f32x4){0.f, 0.f, 0.f, 0.f}, (f32x4){0.f, 0.f, 0.f, 0.f}};
#pragma unroll
              for (int kk = 0; kk < 4; ++kk) { const bf16x8 cf = *(const LAS bf16x8*)(Cm + (ti * 16 + fr) * SB + kk * 32 + fq * 8);
#pragma unroll
                  for (int t = 0; t < 2; ++t) { const bf16x8 bfg = *(const LAS bf16x8*)(Bm + ((tj0 + t) * 16 + fr) * SB + kk * 32 + fq * 8);
                      gacc[t] = __builtin_amdgcn_mfma_f32_16x16x32_bf16(bfg, cf, gacc[t], 0, 0, 0); } }
              const int i = ti * 16 + fr; const float cmi = fa[i];
#pragma unroll
              for (int t = 0; t < 2; ++t) { const int j0 = (tj0 + t) * 16 + fq * 4; float m[4];
                  const f32x4 cj4 = *(const LAS f32x4*)(fa + j0), dj4 = *(const LAS f32x4*)(fa + 192 + j0);
#pragma unroll
                  for (int jj = 0; jj < 4; ++jj) { const int j = j0 + jj; const float lv = __expf(fminf(cmi - cj4[jj], 0.f)) * dj4[jj]; m[jj] = (j <= i) ? gacc[t][jj] * lv : 0.f; }
                  u32x2 o; o.x = cvt_pk_bf16(m[0], m[1]); o.y = cvt_pk_bf16(m[2], m[3]);
                  *(LAS u32x2*)(Mm + i * SX + j0) = o; } }
            { const int pq = tid >> 3, j8 = (tid & 7) * 8; const u32x4 v = *(const LAS u32x4*)(XT + pq * SX + j8);
              const f32x4 wa = *(const LAS f32x4*)(fa + 128 + j8), wb = *(const LAS f32x4*)(fa + 128 + j8 + 4);
              u32x4 o; o.x = cvt_pk_bf16(bflo(v.x) * wa[0], bfhi(v.x) * wa[1]); o.y = cvt_pk_bf16(bflo(v.y) * wa[2], bfhi(v.y) * wa[3]);
              o.z = cvt_pk_bf16(bflo(v.z) * wb[0], bfhi(v.z) * wb[1]); o.w = cvt_pk_bf16(bflo(v.w) * wb[2], bfhi(v.w) * wb[3]);
              *(LAS u32x4*)(XsT + pq * SX + j8) = o; }
            LDS_BARRIER();
            { const int tp = w >> 1, ti0 = (w & 1) * 2;
              f32x4 a1[2] = {(f32x4){0.f, 0.f, 0.f, 0.f}, (f32x4){0.f, 0.f, 0.f, 0.f}}, a2[2] = {(f32x4){0.f, 0.f, 0.f, 0.f}, (f32x4){0.f, 0.f, 0.f, 0.f}};
#pragma unroll
              for (int kk = 0; kk < 2; ++kk) { const bf16x8 af = *(const LAS bf16x8*)(XT + (tp * 16 + fr) * SX + kk * 32 + fq * 8);
#pragma unroll
                  for (int t = 0; t < 2; ++t) { const bf16x8 mf = *(const LAS bf16x8*)(Mm + ((ti0 + t) * 16 + fr) * SX + kk * 32 + fq * 8);
                      a1[t] = __builtin_amdgcn_mfma_f32_16x16x32_bf16(af, mf, a1[t], 0, 0, 0); } }
#pragma unroll
              for (int kk = 0; kk < 4; ++kk) { const bf16x8 hf = *(const LAS bf16x8*)(Hb + (tp * 16 + fr) * SB + kk * 32 + fq * 8);
#pragma unroll
                  for (int t = 0; t < 2; ++t) { const bf16x8 cf = *(const LAS bf16x8*)(Cm + ((ti0 + t) * 16 + fr) * SB + kk * 32 + fq * 8);
                      a2[t] = __builtin_amdgcn_mfma_f32_16x16x32_bf16(hf, cf, a2[t], 0, 0, 0); } }
#pragma unroll
              for (int t = 0; t < 2; ++t) { const int i = (ti0 + t) * 16 + fr; const float ei = fa[64 + i];
                  int row, first, last; seqpos(ci * Q + i, dir, b, row, first, last);
                  const f32x4 yv = a1[t] + a2[t] * ei;
                  u32x2 o; o.x = cvt_pk_bf16(yv[0], yv[1]); o.y = cvt_pk_bf16(yv[2], yv[3]);
                  *(u32x2*)(Y + (size_t)row * DM + dir * 512 + h * 64 + tp * 16 + fq * 4) = o; } }
            if (w == 0 && ci + 1 < NCH) { LAS float* faw = fab + ((ci + 1) & 1) * 256;
                const float xx = dtraw + dtb; const float dt = xx > 20.f ? xx : log1pf(__expf(xx));
                float a = dt * Aneg;
                a = DPP_ADD(a, 0x111); a = DPP_ADD(a, 0x112); a = DPP_ADD(a, 0x114); a = DPP_ADD(a, 0x118);
                const float t15 = __int_as_float(__builtin_amdgcn_readlane(__float_as_int(a), 15));
                const float t31 = __int_as_float(__builtin_amdgcn_readlane(__float_as_int(a), 31));
                const float t47 = __int_as_float(__builtin_amdgcn_readlane(__float_as_int(a), 47));
                a += (lane >= 48) ? (t15 + t31 + t47) : (lane >= 32 ? (t15 + t31) : (lane >= 16 ? t15 : 0.f));
                const float cl = __int_as_float(__builtin_amdgcn_readlane(__float_as_int(a), 63));
                faw[lane] = a; faw[64 + lane] = __expf(a); faw[128 + lane] = __expf(cl - a) * dt; faw[192 + lane] = dt;
            }
            { const float decl = fa[64 + 63];
#pragma unroll
              for (int tp = 0; tp < 4; ++tp) Hacc[tp] = Hacc[tp] * decl;
#pragma unroll
              for (int kk = 0; kk < 2; ++kk) { const bf16x8 af = *(const LAS bf16x8*)(BT + (w * 16 + fr) * SX + kk * 32 + fq * 8);
#pragma unroll
                  for (int tp = 0; tp < 4; ++tp) { const bf16x8 xf = *(const LAS bf16x8*)(XsT + (tp * 16 + fr) * SX + kk * 32 + fq * 8);
                      Hacc[tp] = __builtin_amdgcn_mfma_f32_16x16x32_bf16(af, xf, Hacc[tp], 0, 0, 0); } } }
            LDS_BARRIER();
#pragma unroll
            for (int tp = 0; tp < 4; ++tp) { u32x2 o; o.x = cvt_pk_bf16(Hacc[tp][0], Hacc[tp][1]); o.y = cvt_pk_bf16(Hacc[tp][2], Hacc[tp][3]);
                *(LAS u32x2*)(Hb + (tp * 16 + fr) * SB + w * 16 + fq * 4) = o; }
            if (ci + 1 < NCH) C_STORE();
            dtcur = dtraw;
            LDS_BARRIER();
        }
#undef C_ISSUE
#undef C_STORE
    }
}

__device__ __forceinline__ void mamba_post_phase(const P& p, int l, int r0) {
    const int lane = opq_tid() & 63, wid = opq_tid() >> 6;
    const bf16_t* PM = (const bf16_t*)(p.ws + OFF_PM);
    bf16_t* Y = (bf16_t*)(p.ws + OFF_Y);
    const int ch = lane * 8;
    const float Dh = p.in[16][l * 8 + (lane >> 3)];
    const f32x4 nw0 = *(const f32x4*)(p.in[17] + l * 512 + ch), nw1 = *(const f32x4*)(p.in[17] + l * 512 + ch + 4);
    const bf16_t* XBCp = (const bf16_t*)(p.ws + OFF_HN);
    u32x4 yFA, yBA, zzA, xsA, yFB, yBB, zzB, xsB;
#define MQ_LOAD(X, row_) do { yF##X = *(const u32x4*)(Y + (size_t)(row_) * DM + ch); yB##X = *(const u32x4*)(Y + (size_t)(row_) * DM + 512 + ch); \
        zz##X = *(const u32x4*)(PM + (size_t)(row_) * PMW + ch); xs##X = *(const u32x4*)(XBCp + (size_t)(row_) * 1024 + ch); } while (0)
#define MQ_COMPUTE(X, row_) do { float y[8]; float ss = 0.f; \
        _Pragma("unroll") for (int e = 0; e < 8; ++e) { float t = bfe(yF##X, e) + bfe(yB##X, e) + Dh * bfe(xs##X, e); t *= siluf_(bfe(zz##X, e)); y[e] = t; ss += t * t; } \
        ss += __shfl_xor(ss, 1); ss += __shfl_xor(ss, 2); ss += __shfl_xor(ss, 4); ss += __shfl_xor(ss, 8); ss += __shfl_xor(ss, 16); \
        const float rstd = rsqrtf(ss * (1.f / 256.f) + EPS); u32x4 o; \
        o.x = cvt_pk_bf16(y[0] * rstd * nw0[0], y[1] * rstd * nw0[1]); o.y = cvt_pk_bf16(y[2] * rstd * nw0[2], y[3] * rstd * nw0[3]); \
        o.z = cvt_pk_bf16(y[4] * rstd * nw1[0], y[5] * rstd * nw1[1]); o.w = cvt_pk_bf16(y[6] * rstd * nw1[2], y[7] * rstd * nw1[3]); \
        *(u32x4*)(Y + (size_t)(row_) * DM + ch) = o; } while (0)
    const int rstep = (int)gridDim.x * 8;
    int row = r0 + opq_bid() * 8 + wid;
    if (row < R) MQ_LOAD(A, row);
    while (row < R) {
        int rn = row + rstep;
        if (rn < R) MQ_LOAD(B, rn);
        __builtin_amdgcn_sched_barrier(0);
        MQ_COMPUTE(A, row);
        __builtin_amdgcn_sched_barrier(0);
        row = rn; if (row >= R) break;
        rn = row + rstep;
        if (rn < R) MQ_LOAD(A, rn);
        __builtin_amdgcn_sched_barrier(0);
        MQ_COMPUTE(B, row);
        __builtin_amdgcn_sched_barrier(0);
        row = rn;
    }
#undef MQ_LOAD
#undef MQ_COMPUTE
}

template <int MM>
__device__ __forceinline__ void prep_wload(const P& p, int l, int w, int fr, int fq, const bf16_t* W2t, const bf16_t* A2t, bf16x8 (&pw)[2][4], f32x4 (&pb)[4]) {
    constexpr int d = MM & 1;
    const bf16_t* Wt = MM < 2 ? W2t + d * 512 * 64 : A2t + d * 512 * 64;
#pragma unroll
    for (int k2 = 0; k2 < 2; ++k2)
#pragma unroll
        for (int ns = 0; ns < 4; ++ns) pw[k2][ns] = *(const bf16x8*)(Wt + (size_t)(w * 64 + ns * 16 + fr) * 64 + k2 * 32 + fq * 8);
#pragma unroll
    for (int ns = 0; ns < 4; ++ns) { const int ch = w * 64 + ns * 16 + fq * 4;
        pb[ns] = MM < 2 ? *(const f32x4*)(p.in[19] + (size_t)(l * 2 + d) * 512 + ch) : *(const f32x4*)(p.in[21] + (size_t)(l * 2 + d) * 512 + ch); }
}
template <int MM, bool PRE = false>
__device__ __forceinline__ void prep_mm(const P& p, int l, int row0, int w, int fr, int fq, const LAS bf16_t* XW, const LAS bf16_t* XA, const LAS bf16_t* XG,
                                        const bf16_t* W2t, const bf16_t* A2t, const bf16_t* G2t, bf16_t* D4, bf16_t* G, const bf16x8 (*pw)[4] = nullptr, const f32x4* pb = nullptr) {
    constexpr int LX = 72, LG = 168, TT = 48, NTS = TT / 16;
    constexpr int d = MM & 1, K = MM < 4 ? 64 : 160, LDX = MM < 4 ? LX : LG, NK = K / 32;
    const LAS bf16_t* X = MM < 2 ? XW + d * TT * LX : (MM < 4 ? XA + d * TT * LX : XG);
    const bf16_t* Wt = MM < 2 ? W2t + d * 512 * 64 : (MM < 4 ? A2t + d * 512 * 64 : G2t);
    f32x4 bias[4];
#pragma unroll
    for (int ns = 0; ns < 4; ++ns) { const int ch = w * 64 + ns * 16 + fq * 4;
        if (PRE) bias[ns] = pb[ns];
        else bias[ns] = MM < 2 ? *(const f32x4*)(p.in[19] + (size_t)(l * 2 + d) * 512 + ch) : (MM < 4 ? *(const f32x4*)(p.in[21] + (size_t)(l * 2 + d) * 512 + ch) : (f32x4){0.f, 0.f, 0.f, 0.f}); }
    f32x4 acc[NTS][4];
#pragma unroll
    for (int a = 0; a < NTS; ++a)
#pragma unroll
        for (int c = 0; c < 4; ++c) acc[a][c] = (f32x4){0.f, 0.f, 0.f, 0.f};
#pragma unroll
    for (int k0 = 0; k0 < NK; k0 += 2) {
        bf16x8 af[2][4], bfr[2][NTS];
#pragma unroll
        for (int k2 = 0; k2 < 2; ++k2) if (k0 + k2 < NK) {
#pragma unroll
            for (int ns = 0; ns < 4; ++ns) { if (PRE) af[k2][ns] = pw[k0 + k2][ns]; else af[k2][ns] = *(const bf16x8*)(Wt + (size_t)(w * 64 + ns * 16 + fr) * K + (k0 + k2) * 32 + fq * 8); }
#pragma unroll
            for (int ts = 0; ts < NTS; ++ts) bfr[k2][ts] = *(const LAS bf16x8*)(X + (ts * 16 + fr) * LDX + (k0 + k2) * 32 + fq * 8); }
#pragma unroll
        for (int k2 = 0; k2 < 2; ++k2) if (k0 + k2 < NK) {
#pragma unroll
            for (int ts = 0; ts < NTS; ++ts)
#pragma unroll
                for (int ns = 0; ns < 4; ++ns) acc[ts][ns] = __builtin_amdgcn_mfma_f32_16x16x32_bf16(af[k2][ns], bfr[k2][ts], acc[ts][ns], 0, 0, 0); }
    }
#pragma unroll
    for (int ts = 0; ts < NTS; ++ts)
#pragma unroll
        for (int ns = 0; ns < 4; ++ns) {
            const int row = row0 + ts * 16 + fr, ch = w * 64 + ns * 16 + fq * 4;
            f32x4 v = acc[ts][ns];
            if (MM < 2) {
#pragma unroll
                for (int e = 0; e < 4; ++e) v[e] = -0.6065306597126334f * sigmoidf_(bias[ns][e] + v[e]); }
            else if (MM < 4) {
#pragma unroll
                for (int e = 0; e < 4; ++e) v[e] = sigmoidf_(bias[ns][e] + v[e]); }
            u32x2 o; o.x = cvt_pk_bf16(v[0], v[1]); o.y = cvt_pk_bf16(v[2], v[3]);
            bf16_t* dst = MM < 2 ? D4 + (size_t)row * 2048 + d * 512 + ch : (MM < 4 ? D4 + (size_t)row * 2048 + 1024 + d * 512 + ch : G + (size_t)row * 512 + ch);
            *(u32x2*)dst = o;
        }
}
__device__ __forceinline__ void rwkv_prep_phase(LAS unsigned char* lds, const P& p, int l) {
    constexpr int LX = 72, LG = 168, NIT = 4, TT = 48;
    LAS bf16_t* XW = (LAS bf16_t*)lds;
    LAS bf16_t* XA = XW + 2 * TT * LX;
    LAS bf16_t* XG = XA + 2 * TT * LX;
    const int tid = opq_tid(), lane = tid & 63, w = tid >> 6, fr = lane & 15, fq = lane >> 4;
    const bf16_t* PR = (const bf16_t*)(p.ws + OFF_PR);
    bf16_t* D4 = (bf16_t*)(p.ws + OFF_D4); bf16_t* G = (bf16_t*)(p.ws + OFF_G);
    const bf16_t* W2t = (const bf16_t*)(p.ws + OFF_LORA); const bf16_t* A2t = W2t + 2 * 512 * 64; const bf16_t* G2t = A2t + 2 * 512 * 64;
    const float* mu = p.in[18] + (size_t)l * RCOLS;
    for (int tile = opq_bid(); tile < R / TT; tile += gridDim.x) {
        const int row0 = tile * TT;
        bf16x8 wA[2][4], wB[2][4]; f32x4 bA[4], bB[4];
        prep_wload<0>(p, l, w, fr, fq, W2t, A2t, wA, bA);
        __syncthreads();
#pragma unroll 1
        for (int bi = 0; bi < 2; ++bi) {
        u32x4 cu[NIT], pv[NIT], nv[NIT];
#pragma unroll
        for (int i = 0; i < NIT; ++i) {
            const int it = tid + (bi * NIT + i) * 512; const bool valid = it < TT * 52;
            const int j = it / 52, cgi = it % 52, row = row0 + j, col = 1536 + cgi * 8;
            int first, last, mrow; row_info(row, first, last, mrow);
            const u32x4 z4 = (u32x4){0u, 0u, 0u, 0u};
            if (valid) { const bf16_t* src = PR + (size_t)row * PRW + col;
                cu[i] = *(const u32x4*)src; pv[i] = first ? z4 : *(const u32x4*)(src - PRW); nv[i] = last ? z4 : *(const u32x4*)(src + PRW); }
            else { cu[i] = z4; pv[i] = z4; nv[i] = z4; }
        }
#pragma unroll
        for (int i = 0; i < NIT; ++i) {
            const int it = tid + (bi * NIT + i) * 512; const bool valid = it < TT * 52;
            const int j = it / 52, cgi = it % 52;
            const f32x4 m0 = *(const f32x4*)(mu + 1536 + cgi * 8), m1 = *(const f32x4*)(mu + 1536 + cgi * 8 + 4);
            float s[8];
#pragma unroll
            for (int e = 0; e < 8; ++e) { const float u = bfe(cu[i], e); const float mm_ = e < 4 ? m0[e & 3] : m1[e & 3]; s[e] = u + mm_ * (0.5f * (bfe(pv[i], e) + bfe(nv[i], e)) - u); }
            LAS bf16_t* dst;
            if (cgi < 16) { const int d = cgi >> 3, kk = (cgi & 7) * 8; dst = XW + (d * TT + j) * LX + kk;
#pragma unroll
                for (int e = 0; e < 8; ++e) s[e] = tanhf_(s[e]); }
            else if (cgi < 32) { const int c2 = cgi - 16, d = c2 >> 3, kk = (c2 & 7) * 8; dst = XA + (d * TT + j) * LX + kk; }
            else { const int kk = (cgi - 32) * 8; dst = XG + j * LG + kk;
#pragma unroll
                for (int e = 0; e < 8; ++e) s[e] = sigmoidf_(s[e]); }
            u32x4 o; o.x = cvt_pk_bf16(s[0], s[1]); o.y = cvt_pk_bf16(s[2], s[3]); o.z = cvt_pk_bf16(s[4], s[5]); o.w = cvt_pk_bf16(s[6], s[7]);
            if (valid) *(LAS u32x4*)dst = o;
        }
        }
        __syncthreads();
        prep_wload<1>(p, l, w, fr, fq, W2t, A2t, wB, bB);
        prep_mm<0, true>(p, l, row0, w, fr, fq, XW, XA, XG, W2t, A2t, G2t, D4, G, wA, bA);
        prep_wload<2>(p, l, w, fr, fq, W2t, A2t, wA, bA);
        prep_mm<1, true>(p, l, row0, w, fr, fq, XW, XA, XG, W2t, A2t, G2t, D4, G, wB, bB);
        prep_wload<3>(p, l, w, fr, fq, W2t, A2t, wB, bB);
        prep_mm<2, true>(p, l, row0, w, fr, fq, XW, XA, XG, W2t, A2t, G2t, D4, G, wA, bA);
        prep_mm<3, true>(p, l, row0, w, fr, fq, XW, XA, XG, W2t, A2t, G2t, D4, G, wB, bB);
        prep_mm<4>(p, l, row0, w, fr, fq, XW, XA, XG, W2t, A2t, G2t, D4, G);
    }
}

__device__ __forceinline__ void rwkv_scan_phase(LAS unsigned char* lds, const P& p, int l) {
    constexpr int T = 32, NCH = (CTX + SEQ) / T, BUF = 6 * T * 64;
    LAS float* base = (LAS float*)lds;
    LAS float* ob = base + 2 * BUF;
    const int tid = opq_tid();
    const bf16_t* PR = (const bf16_t*)(p.ws + OFF_PR);
    bf16_t* D4 = (bf16_t*)(p.ws + OFF_D4);
    const float* mu = p.in[18] + (size_t)l * RCOLS;
    for (int q = opq_bid(); q < 256; q += gridDim.x) {
        const int b = q >> 4, h = (q >> 1) & 7, dir = q & 1;
        const int vv_ = tid >> 3, part = tid & 7;
        f32x2 S2[2][4];
#pragma unroll
        for (int i = 0; i < 4; ++i) { S2[0][i] = (f32x2){0.f, 0.f}; S2[1][i] = (f32x2){0.f, 0.f}; }
        const int w = tid >> 6, rp = (tid >> 3) & 31;
        const int lj = tid >> 4, c4 = (tid & 15) * 4, hc = h * 64 + c4;
        f32x4 mur, muk, muv, kkw, kaw, rkw;
#pragma unroll
        for (int e = 0; e < 4; ++e) { mur[e] = mu[hc + e]; muk[e] = mu[512 + hc + e]; muv[e] = mu[1024 + hc + e];
            kkw[e] = p.in[24][l * 512 + hc + e]; kaw[e] = p.in[25][l * 512 + hc + e]; rkw[e] = p.in[26][l * 512 + hc + e]; }
        float* BON = (float*)(p.ws + OFF_DT);
        u32x2 lrA[3], lkA[3], lvA[3], llwA, laA, lrB[3], lkB[3], lvB[3], llwB, laB;
#define R_ISSUE(ci, LJ, X) do { int row, first, last; seqpos((ci) * T + (LJ), dir, b, row, first, last); const u32x2 z2 = (u32x2){0u, 0u}; \
            const bf16_t* src = PR + (size_t)row * PRW + hc; \
            lr##X[1] = *(const u32x2*)src; lk##X[1] = *(const u32x2*)(src + 512); lv##X[1] = *(const u32x2*)(src + 1024); \
            if (first) { lr##X[0] = z2; lk##X[0] = z2; lv##X[0] = z2; } else { lr##X[0] = *(const u32x2*)(src - PRW); lk##X[0] = *(const u32x2*)(src - PRW + 512); lv##X[0] = *(const u32x2*)(src - PRW + 1024); } \
            if (last) { lr##X[2] = z2; lk##X[2] = z2; lv##X[2] = z2; } else { lr##X[2] = *(const u32x2*)(src + PRW); lk##X[2] = *(const u32x2*)(src + PRW + 512); lv##X[2] = *(const u32x2*)(src + PRW + 1024); } \
            llw##X = *(const u32x2*)(D4 + (size_t)row * 2048 + dir * 512 + hc); la##X = *(const u32x2*)(D4 + (size_t)row * 2048 + 1024 + dir * 512 + hc); } while (0)
#define R_PROCESS(ci, LJ, X) do { LAS float* bb = base + ((ci) & 1) * BUF + (LJ) * 64 + c4; \
            f32x4 rr, kx, vx, kkv, av, wv; float ss = 0.f; \
            _Pragma("unroll") for (int e = 0; e < 4; ++e) { \
                const float ur = bfe2(lr##X[1], e), uk = bfe2(lk##X[1], e), uv = bfe2(lv##X[1], e); \
                rr[e] = ur + mur[e] * (0.5f * (bfe2(lr##X[0], e) + bfe2(lr##X[2], e)) - ur); \
                kx[e] = uk + muk[e] * (0.5f * (bfe2(lk##X[0], e) + bfe2(lk##X[2], e)) - uk); \
                vx[e] = uv + muv[e] * (0.5f * (bfe2(lv##X[0], e) + bfe2(lv##X[2], e)) - uv); \
                kkv[e] = kx[e] * kkw[e]; ss += kkv[e] * kkv[e]; av[e] = bfe2(la##X, e); wv[e] = __expf(bfe2(llw##X, e)); } \
            ss = red16(ss); \
            const float inv = 1.f / fmaxf(sqrtf(ss), 1e-12f); \
            f32x4 bv, kdv, nkk; \
            float bsum = 0.f; \
            _Pragma("unroll") for (int e = 0; e < 4; ++e) { kkv[e] *= inv; bv[e] = kkv[e] * av[e]; nkk[e] = -kkv[e]; kdv[e] = kx[e] * (1.f + (av[e] - 1.f) * kaw[e]); bsum += rr[e] * kdv[e] * rkw[e]; } \
            bsum = red16(bsum); \
            if ((tid & 15) == 0) { int row_, f_, l_; seqpos((ci) * T + (LJ), dir, b, row_, f_, l_); BON[((size_t)dir * R + row_) * 8 + h] = bsum; } \
            *(LAS f32x4*)(bb + 0 * T * 64) = wv; *(LAS f32x4*)(bb + 1 * T * 64) = bv; *(LAS f32x4*)(bb + 2 * T * 64) = kdv; \
            *(LAS f32x4*)(bb + 3 * T * 64) = nkk; *(LAS f32x4*)(bb + 4 * T * 64) = rr; *(LAS f32x4*)(bb + 5 * T * 64) = vx; } while (0)
#define R_FLUSH(cc, LJ) do { int row, first, last; seqpos((cc) * T + (LJ), dir, b, row, first, last); \
            const f32x4 ov = *(const LAS f32x4*)(ob + ((cc) & 1) * T * 64 + (LJ) * 64 + c4); \
            u32x2 o2; o2.x = cvt_pk_bf16(ov[0], ov[1]); o2.y = cvt_pk_bf16(ov[2], ov[3]); \
            *(u32x2*)(D4 + (size_t)row * 2048 + dir * 512 + hc) = o2; } while (0)
        const int ljA = (tid - 256) >> 4, ljB = ljA + 16;
        __syncthreads();
        R_ISSUE(0, lj, A); R_PROCESS(0, lj, A);
        __syncthreads();
        for (int ci = 0; ci < NCH; ++ci) {
            const LAS float* cb = base + (ci & 1) * BUF;
            LAS float* obw = ob + (ci & 1) * T * 64;
            if (w < 4) {
#define RV_LOAD(P_, j_) do { const LAS float* pj = cb + (j_) * 64 + part * 4; \
                P_##w0 = *(const LAS f32x4*)(pj); P_##w1 = *(const LAS f32x4*)(pj + 32); \
                P_##b0 = *(const LAS f32x4*)(pj + T * 64); P_##b1 = *(const LAS f32x4*)(pj + T * 64 + 32); \
                P_##k0 = *(const LAS f32x4*)(pj + 2 * T * 64); P_##k1 = *(const LAS f32x4*)(pj + 2 * T * 64 + 32); \
                P_##n0 = *(const LAS f32x4*)(pj + 3 * T * 64); P_##n1 = *(const LAS f32x4*)(pj + 3 * T * 64 + 32); \
                P_##r0 = *(const LAS f32x4*)(pj + 4 * T * 64); P_##r1 = *(const LAS f32x4*)(pj + 4 * T * 64 + 32); \
                P_##vt = *(const LAS f32x2*)(cb + 5 * T * 64 + (j_) * 64 + rp * 2); } while (0)
#define RV_V4(x_) {(f32x2){x_##0[0], x_##0[1]}, (f32x2){x_##0[2], x_##0[3]}, (f32x2){x_##1[0], x_##1[1]}, (f32x2){x_##1[2], x_##1[3]}}
#define RV_COMPUTE(P_, jj_) do { const f32x2 w_[4] = RV_V4(P_##w), b_[4] = RV_V4(P_##b), k_[4] = RV_V4(P_##k), n_[4] = RV_V4(P_##n), r_[4] = RV_V4(P_##r); \
                _Pragma("unroll") for (int u = 0; u < 2; ++u) { \
                    f32x2 sa2 = S2[u][0] * n_[0]; sa2 = S2[u][1] * n_[1] + sa2; sa2 = S2[u][2] * n_[2] + sa2; sa2 = S2[u][3] * n_[3] + sa2; \
                    const float sa = red8(sa2[0] + sa2[1]); \
                    const f32x2 sav = (f32x2){sa, sa}, vtv = (f32x2){P_##vt[u], P_##vt[u]}; \
                    f32x2 o2 = (f32x2){0.f, 0.f}; \
                    _Pragma("unroll") for (int q2 = 0; q2 < 4; ++q2) { f32x2 t = vtv * k_[q2]; t = sav * b_[q2] + t; S2[u][q2] = S2[u][q2] * w_[q2] + t; o2 = S2[u][q2] * r_[q2] + o2; } \
                    const float o = red8(o2[0] + o2[1]); \
                    if (part == (jj_)) ocap[u] = o; } } while (0)
                f32x4 Aw0, Aw1, Ab0, Ab1, Ak0, Ak1, An0, An1, Ar0, Ar1, Bw0, Bw1, Bb0, Bb1, Bk0, Bk1, Bn0, Bn1, Br0, Br1; f32x2 Avt, Bvt;
                __builtin_amdgcn_s_setprio(3);
                RV_LOAD(A, 0);
#pragma unroll 1
                for (int j0 = 0; j0 < T; j0 += 8) {
                    f32x2 ocap = (f32x2){0.f, 0.f};
#pragma unroll
                    for (int jj = 0; jj < 8; jj += 2) {
                        RV_LOAD(B, j0 + jj + 1);
                        __builtin_amdgcn_sched_barrier(0);
                        RV_COMPUTE(A, jj);
                        __builtin_amdgcn_sched_barrier(0);
                        if (j0 + jj + 2 < T) RV_LOAD(A, j0 + jj + 2);
                        __builtin_amdgcn_sched_barrier(0);
                        RV_COMPUTE(B, jj + 1);
                        __builtin_amdgcn_sched_barrier(0);
                    }
                    *(LAS f32x2*)(obw + (j0 + part) * 64 + rp * 2) = ocap;
                }
                __builtin_amdgcn_s_setprio(0);
#undef RV_LOAD
#undef RV_V4
#undef RV_COMPUTE
            }
            else {
                if (ci + 1 < NCH) { R_ISSUE(ci + 1, ljA, A); R_ISSUE(ci + 1, ljB, B); }
                if (ci > 0) { R_FLUSH(ci - 1, ljA); R_FLUSH(ci - 1, ljB); }
                if (ci + 1 < NCH) { R_PROCESS(ci + 1, ljA, A); R_PROCESS(ci + 1, ljB, B); }
            }
            LDS_BARRIER();
        }
        if (w >= 4) { R_FLUSH(NCH - 1, ljA); R_FLUSH(NCH - 1, ljB); }
#undef R_FLUSH
#undef R_ISSUE
#undef R_PROCESS
    }
}

__device__ __forceinline__ void rwkv_post_phase(const P& p, int l, int r0) {
    const int lane = opq_tid() & 63, wid = opq_tid() >> 6;
    const bf16_t* PR = (const bf16_t*)(p.ws + OFF_PR);
    const bf16_t* D4 = (const bf16_t*)(p.ws + OFF_D4); const bf16_t* G = (const bf16_t*)(p.ws + OFF_G);
    bf16_t* Y = (bf16_t*)(p.ws + OFF_Y);
    const float* mu = p.in[18] + (size_t)l * RCOLS;
    const int ch = lane * 8;
    float mur[8], muk[8], muv[8], kaw[8], rkw[8], lnw[8], lnb[8];
#pragma unroll
    for (int hh = 0; hh < 2; ++hh) {
        const f32x4 a0 = *(const f32x4*)(mu + ch + hh * 4), a1 = *(const f32x4*)(mu + 512 + ch + hh * 4), a2 = *(const f32x4*)(mu + 1024 + ch + hh * 4);
        const f32x4 a3 = *(const f32x4*)(p.in[25] + l * 512 + ch + hh * 4), a4 = *(const f32x4*)(p.in[26] + l * 512 + ch + hh * 4);
        const f32x4 a5 = *(const f32x4*)(p.in[27] + l * 512 + ch + hh * 4), a6 = *(const f32x4*)(p.in[28] + l * 512 + ch + hh * 4);
#pragma unroll
        for (int e = 0; e < 4; ++e) { mur[hh * 4 + e] = a0[e]; muk[hh * 4 + e] = a1[e]; muv[hh * 4 + e] = a2[e]; kaw[hh * 4 + e] = a3[e]; rkw[hh * 4 + e] = a4[e]; lnw[hh * 4 + e] = a5[e]; lnb[hh * 4 + e] = a6[e]; }
    }
    const float* BON = (const float*)(p.ws + OFF_DT);
    const u32x4 z4 = (u32x4){0u, 0u, 0u, 0u};
    u32x4 vcA, vpA, vnA, oFA, oBA, ggA, vcB, vpB, vnB, oFB, oBB, ggB; float b0A, b1A, b0B, b1B; int flA = 0, flB = 0;
#define RQ_LOAD(X, row_) do { int f_, l_, m_; row_info(row_, f_, l_, m_); const bf16_t* src = PR + (size_t)(row_) * PRW + 1024 + ch; \
        vc##X = *(const u32x4*)src; vp##X = *(const u32x4*)(src - (f_ ? 0 : PRW)); vn##X = *(const u32x4*)(src + (l_ ? 0 : PRW)); fl##X = f_ | (l_ << 1); \
        const bf16_t* d4 = D4 + (size_t)(row_) * 2048 + ch; oF##X = *(const u32x4*)d4; oB##X = *(const u32x4*)(d4 + 512); \
        gg##X = *(const u32x4*)(G + (size_t)(row_) * 512 + ch); \
        b0##X = BON[(size_t)(row_) * 8 + (lane >> 3)]; b1##X = BON[((size_t)R + (row_)) * 8 + (lane >> 3)]; } while (0)
#define RQ_COMPUTE(X, row_) do { const float bs = b0##X + b1##X; float o[8], vx[8]; float sum = 0.f; const u32x4 vp_ = (fl##X & 1) ? z4 : vp##X, vn_ = (fl##X & 2) ? z4 : vn##X; \
        _Pragma("unroll") for (int e = 0; e < 8; ++e) { const float uv = bfe(vc##X, e); \
            vx[e] = uv + muv[e] * (0.5f * (bfe(vp_, e) + bfe(vn_, e)) - uv); o[e] = bfe(oF##X, e) + bfe(oB##X, e); sum += o[e]; } \
        sum = red8(sum); const float mean = sum * (1.f / 64.f); float var = 0.f; \
        _Pragma("unroll") for (int e = 0; e < 8; ++e) { o[e] -= mean; var += o[e] * o[e]; } \
        var = red8(var); const float rstd = rsqrtf(var * (1.f / 64.f) + 64e-5f); float out[8]; \
        _Pragma("unroll") for (int e = 0; e < 8; ++e) { const float on = o[e] * rstd * lnw[e] + lnb[e]; out[e] = (on + bs * vx[e]) * bfe(gg##X, e); } \
        u32x4 w; w.x = cvt_pk_bf16(out[0], out[1]); w.y = cvt_pk_bf16(out[2], out[3]); w.z = cvt_pk_bf16(out[4], out[5]); w.w = cvt_pk_bf16(out[6], out[7]); \
        *(u32x4*)(Y + (size_t)(row_) * DM + 512 + ch) = w; } while (0)
    const int rstep = (int)gridDim.x * 8;
    int row = r0 + opq_bid() * 8 + wid;
    if (row < R) RQ_LOAD(A, row);
    while (row < R) {
        int rn = row + rstep;
        if (rn < R) RQ_LOAD(B, rn);
        __builtin_amdgcn_sched_barrier(0);
        RQ_COMPUTE(A, row);
        __builtin_amdgcn_sched_barrier(0);
        row = rn; if (row >= R) break;
        rn = row + rstep;
        if (rn < R) RQ_LOAD(A, rn);
        __builtin_amdgcn_sched_barrier(0);
        RQ_COMPUTE(B, row);
        __builtin_amdgcn_sched_barrier(0);
        row = rn;
    }
#undef RQ_LOAD
#undef RQ_COMPUTE
}

__device__ __forceinline__ void gate_phase(const P& p, int l, int r0, int gvbase) {
    bf16_t* GV = (bf16_t*)(p.ws + OFF_GV);
    const float* cwt = p.in[30] + (size_t)l * 9 * DFF; const float* cbs = p.in[31] + (size_t)l * DFF;
    const int nstrip_ctx = (r0 < RC) ? RC / 16 : 0, nstrip = nstrip_ctx + RL / 16;
    const int gthr = opq_bid() * 512 + opq_tid(), nslots = ((int)gridDim.x * 512) / 352;
    const int c8 = (gthr % 352) * 8, s0 = gthr / 352;
    f32x4 wa[9], wb[9];
#pragma unroll
    for (int k = 0; k < 9; ++k) { wa[k] = *(const f32x4*)(cwt + (size_t)k * DFF + c8); wb[k] = *(const f32x4*)(cwt + (size_t)k * DFF + c8 + 4); }
    const f32x4 ba = *(const f32x4*)(cbs + c8), bb = *(const f32x4*)(cbs + c8 + 4);
    for (int sid = (s0 < nslots ? s0 : nstrip); sid < nstrip; sid += nslots) {
        int row0, Wd, Hh, yy, x0;
        if (sid < nstrip_ctx) { row0 = sid * 16; Wd = CTX; Hh = 1; yy = 0; x0 = row0 & (CTX - 1); }
        else { const int r2 = (sid - nstrip_ctx) * 16; row0 = RC + r2; Wd = 64; Hh = 32; const int t = r2 & (SEQ - 1); yy = t >> 6; x0 = t & 63; }
        const bool vup = (yy > 0), vdn = (yy + 1 < Hh);
        const bf16_t* gp = GV + (size_t)(row0 - gvbase) * NUP + c8;
        const u32x4 z4 = (u32x4){0u, 0u, 0u, 0u};
        const long upo = vup ? -(long)Wd * NUP : 0, dno = vdn ? (long)Wd * NUP : 0;
        u32x4 L[3], C[3], Rr[3], Nn[3];
#define G_COL(dst, dx, ok) do { const bool _ok = (ok); const bf16_t* q = gp + (long)(_ok ? (dx) : 0) * NUP; \
            const u32x4 _a = *(const u32x4*)(q + upo), _b = *(const u32x4*)q, _c = *(const u32x4*)(q + dno); \
            dst[0] = (_ok && vup) ? _a : z4; dst[1] = _ok ? _b : z4; dst[2] = (_ok && vdn) ? _c : z4; } while (0)
        G_COL(L, -1, x0 > 0); G_COL(C, 0, true); G_COL(Rr, 1, x0 + 1 < Wd);
        u32x4 vv = *(const u32x4*)(gp + DFF), vvn = z4;
#pragma unroll
        for (int i = 0; i < 16; ++i) {
            if (i + 2 <= 16) G_COL(Nn, i + 2, x0 + i + 2 < Wd);
            if (i + 1 < 16) vvn = *(const u32x4*)(gp + (long)(i + 1) * NUP + DFF);
            float acc[8];
#pragma unroll
            for (int e = 0; e < 4; ++e) { acc[e] = ba[e]; acc[4 + e] = bb[e]; }
#pragma unroll
            for (int ky = 0; ky < 3; ++ky)
#pragma unroll
                for (int e = 0; e < 4; ++e) {
                    acc[e] += wa[ky * 3 + 0][e] * bfe(L[ky], e) + wa[ky * 3 + 1][e] * bfe(C[ky], e) + wa[ky * 3 + 2][e] * bfe(Rr[ky], e);
                    acc[4 + e] += wb[ky * 3 + 0][e] * bfe(L[ky], 4 + e) + wb[ky * 3 + 1][e] * bfe(C[ky], 4 + e) + wb[ky * 3 + 2][e] * bfe(Rr[ky], 4 + e); }
            float o[8];
#pragma unroll
            for (int e = 0; e < 8; ++e) { const float x = acc[e]; const float u2 = 1.5957691216057308f * (x + 0.044715f * x * x * x);
                o[e] = x * __builtin_amdgcn_rcpf(1.f + __expf(-u2)) * bfe(vv, e); }
            u32x4 w; w.x = cvt_pk_bf16(o[0], o[1]); w.y = cvt_pk_bf16(o[2], o[3]); w.z = cvt_pk_bf16(o[4], o[5]); w.w = cvt_pk_bf16(o[6], o[7]);
            *(u32x4*)(GV + (size_t)(row0 + i - gvbase) * NUP + DFF + c8) = w;
#pragma unroll
            for (int ky = 0; ky < 3; ++ky) { L[ky] = C[ky]; C[ky] = Rr[ky]; Rr[ky] = Nn[ky]; }
            vv = vvn;
        }
#undef G_COL
    }
}

__global__ void __launch_bounds__(512, 2) fwd_megakernel(P p) {
    extern __shared__ __attribute__((aligned(16))) unsigned char lds_raw[];
    LAS unsigned char* lds = (LAS unsigned char*)lds_raw;
    cg::grid_group grid = cg::this_grid();
    unsigned char* ws = p.ws;
    float* ctxres = (float*)(ws + OFF_CTX);
    bf16_t* HN = (bf16_t*)(ws + OFF_HN); bf16_t* HN2 = (bf16_t*)(ws + OFF_HN2);
    bf16_t* PMp = (bf16_t*)(ws + OFF_PM); bf16_t* PRp = (bf16_t*)(ws + OFF_PR); float* DTp = (float*)(ws + OFF_DT);
    bf16_t* Yp = (bf16_t*)(ws + OFF_Y); bf16_t* MRAW = (bf16_t*)(ws + OFF_MRAW); bf16_t* GV = (bf16_t*)(ws + OFF_GV);
    const bf16_t* WIN = (const bf16_t*)(ws + OFF_WIN); const bf16_t* WOUT = (const bf16_t*)(ws + OFF_WOUT);
    const bf16_t* WUP = (const bf16_t*)(ws + OFF_WUP); const bf16_t* WDN = (const bf16_t*)(ws + OFF_WDN);
    const int G = gridDim.x, c = blockIdx.x;
    volatile LAS unsigned* xst = (volatile LAS unsigned*)(lds + 131072);
    if (threadIdx.x < 2) xst[threadIdx.x] = 0u;
    __syncthreads();
    (void)xcd_barrier_post((unsigned*)(ws + OFF_BAR), xst);

    mod_phase(lds, p);
    convert_weights(lds, p, 0);
    grid.sync();
    row_phase<false, true>(p, 0, 0, 0, R, p.in[0], p.in[2], nullptr, 0, 0, nullptr, 0, nullptr, nullptr, p.in[6], 0, HN, 0);
    xcd_barrier((unsigned*)(ws + OFF_BAR), (volatile LAS unsigned*)(lds + 131072));
#pragma unroll 1
    for (int l = 0; l < 2; ++l) {
        const float* xlat = l == 0 ? p.in[0] : p.out;
        const float* xctx = l == 0 ? p.in[2] : ctxres;
        { pg8::Gemm g{HN, WIN, R, NIN, DM, DM}; pg8::StaticOrder S; S.init(R, NIN, G, c, WGM_IN); pg8::EpiInProj E{PMp, PRp, DTp}; pg8::gemm_phase(lds, g, S, E); }
        xcd_barrier((unsigned*)(ws + OFF_BAR), (volatile LAS unsigned*)(lds + 131072));
        xbc_phase(p, l);
        xcd_barrier((unsigned*)(ws + OFF_BAR), (volatile LAS unsigned*)(lds + 131072));
        mamba_chunk_phase(lds, p, l);
        xcd_barrier((unsigned*)(ws + OFF_BAR), (volatile LAS unsigned*)(lds + 131072));
        mamba_post_phase(p, l, l == 0 ? 0 : RC);
        xcd_barrier((unsigned*)(ws + OFF_BAR), (volatile LAS unsigned*)(lds + 131072));
        rwkv_prep_phase(lds, p, l);
        xcd_barrier((unsigned*)(ws + OFF_BAR), (volatile LAS unsigned*)(lds + 131072));
        rwkv_scan_phase(lds, p, l);
        xcd_barrier((unsigned*)(ws + OFF_BAR), (volatile LAS unsigned*)(lds + 131072));
        rwkv_post_phase(p, l, l == 0 ? 0 : RC);
        xcd_barrier((unsigned*)(ws + OFF_BAR), (volatile LAS unsigned*)(lds + 131072));
        const int rs = l == 0 ? 0 : RC;
        { pg8::Gemm g{Yp + (size_t)rs * DM, WOUT, R - rs, DM, DM, DM}; pg8::StaticOrder S; S.init(R - rs, DM, G, c, WGM_OUT); pg8::EpiStore E{MRAW + (size_t)rs * DM, DM}; pg8::gemm_phase(lds, g, S, E); }
        xcd_barrier((unsigned*)(ws + OFF_BAR), (volatile LAS unsigned*)(lds + 131072));
        const int nrange = l == 0 ? 2 : 1;
        const int f0 = rs, f1 = l == 0 ? 32768 : R;
        row_phase<true, true>(p, l, l, f0, f1, xlat, xctx, MRAW, DM, 0, p.in[7] + l * DM, 2048, p.out, ctxres, p.in[8] + l * DM, 3072, HN2, f0);
        if (f1 < R) row_phase<true, false>(p, l, l, f1, R, xlat, xctx, MRAW, DM, 0, p.in[7] + l * DM, 2048, p.out, ctxres, nullptr, 0, nullptr, 0);
        xcd_barrier((unsigned*)(ws + OFF_BAR), (volatile LAS unsigned*)(lds + 131072));
        for (int ri = 0; ri < nrange; ++ri) {
            const int a0 = ri == 0 ? f0 : f1, a1 = ri == 0 ? f1 : R;
            if (ri > 0) {
                row_phase<false, true>(p, l, l, a0, a1, p.out, ctxres, nullptr, 0, 0, nullptr, 0, nullptr, nullptr, p.in[8] + l * DM, 3072, HN2, a0);
                xcd_barrier((unsigned*)(ws + OFF_BAR), (volatile LAS unsigned*)(lds + 131072));
            }
            { pg8::Gemm g{HN2, WUP, a1 - a0, NUP, DM, DM}; pg8::StaticOrder S; S.init(a1 - a0, NUP, G, c, WGM_UP); pg8::EpiStore E{GV + (size_t)(a0 - rs) * NUP, NUP}; pg8::gemm_phase(lds, g, S, E); }
            xcd_barrier((unsigned*)(ws + OFF_BAR), (volatile LAS unsigned*)(lds + 131072));
        }
        gate_phase(p, l, rs, rs);
        xcd_barrier((unsigned*)(ws + OFF_BAR), (volatile LAS unsigned*)(lds + 131072));
        { pg8::Gemm g{GV + DFF, WDN, R - rs, DM, DFF, NUP}; pg8::StaticOrder S; S.init(R - rs, DM, G, c, WGM_DN); pg8::EpiStore E{GV, NUP}; pg8::gemm_phase(lds, g, S, E); }
        xcd_barrier((unsigned*)(ws + OFF_BAR), (volatile LAS unsigned*)(lds + 131072));
        if (l == 0) {
            convert_weights(lds, p, 1);
            row_phase<true, false>(p, 0, 0, 0, R, p.out, ctxres, GV, NUP, 0, p.in[9], 5120, p.out, ctxres, nullptr, 0, nullptr, 0);
            xcd_barrier((unsigned*)(ws + OFF_BAR), (volatile LAS unsigned*)(lds + 131072));
            row_phase<false, true>(p, 1, 1, 0, R, p.out, ctxres, nullptr, 0, 0, nullptr, 0, nullptr, nullptr, p.in[6] + DM, 0, HN, 0);
            xcd_barrier((unsigned*)(ws + OFF_BAR), (volatile LAS unsigned*)(lds + 131072));
        } else {
            row_phase<true, false>(p, 1, 1, RC, R, p.out, ctxres, GV, NUP, RC, p.in[9] + DM, 5120, p.out, ctxres, nullptr, 0, nullptr, 0);
        }
    }
}

extern "C" void kernel_launch(void* const* d_in, const int* in_sizes, int n_in, void* d_out, int out_size, void* d_ws, size_t ws_size, hipStream_t stream) {
    static int grid_blocks = 0;
    if (grid_blocks == 0) {
        if (n_in != 33 || ws_size < WS_NEED) { fprintf(stderr, "kernel_launch: unexpected n_in %d or ws_size %zu (< %zu)\n", n_in, ws_size, (size_t)WS_NEED); grid_blocks = -1; return; }
        int dev = 0, cus = 0, per_cu = 0;
        hipGetDevice(&dev);
        hipDeviceGetAttribute(&cus, hipDeviceAttributeMultiprocessorCount, dev);
        hipFuncSetAttribute((const void*)fwd_megakernel, hipFuncAttributeMaxDynamicSharedMemorySize, LDS_BYTES);
        hipOccupancyMaxActiveBlocksPerMultiprocessor(&per_cu, (const void*)fwd_megakernel, 512, LDS_BYTES);
        if (per_cu < 1) { fprintf(stderr, "kernel_launch: occupancy query says %d blocks per CU\n", per_cu); per_cu = 1; }
        grid_blocks = cus * 1;
        fprintf(stderr, "kernel_launch: cus %d per_cu %d grid %d ws %zu\n", cus, per_cu, grid_blocks, ws_size);
    }
    if (grid_blocks < 0) return;
    P p{};
    for (int i = 0; i < 33; ++i) p.in[i] = (const float*)d_in[i];
    p.out = (float*)d_out; p.ws = (unsigned char*)d_ws;
    hipMemsetAsync((unsigned char*)d_ws + OFF_BAR, 0, XCD_BAR_WORDS * 4, stream);
    void* args[] = {&p};
    hipError_t e = hipLaunchCooperativeKernel((const void*)fwd_megakernel, dim3(grid_blocks), dim3(512), args, LDS_BYTES, stream);
    if (e != hipSuccess) fprintf(stderr, "cooperative launch failed: %s (grid %d)\n", hipGetErrorString(e), grid_blocks);
}
```

```cpp
#include <hip/hip_runtime.h>
#include <hip/hip_cooperative_groups.h>
#include <cstdio>
#include <cstdint>
namespace cg = cooperative_groups;

#define LAS __attribute__((address_space(3)))
typedef unsigned short bf16_t;
typedef short bf16x8 __attribute__((ext_vector_type(8)));
typedef float f32x4 __attribute__((ext_vector_type(4)));
typedef unsigned u32x4 __attribute__((ext_vector_type(4)));
typedef unsigned u32x2 __attribute__((ext_vector_type(2)));
typedef float f32x2 __attribute__((ext_vector_type(2)));

constexpr int DM = 1024, NB = 16, SEQ = 2048, CTX = 256;
constexpr int RC = NB * CTX, RL = NB * SEQ, R = RC + RL;
constexpr int NIN = 3584;
constexpr int PMW = 1536, PRW = 2048;
constexpr int DFF = 2816, NUP = 5632;
constexpr int RCOLS = 1952;
constexpr float EPS = 1e-6f;

constexpr size_t MiB = 1u << 20;
constexpr size_t OFF_MOD = 0, OFF_LORA = 1 * MiB, OFF_WIN = 2 * MiB, OFF_WOUT = 9 * MiB, OFF_WUP = 11 * MiB, OFF_WDN = 22 * MiB;
constexpr size_t OFF_CTX = 28 * MiB, OFF_DT = 44 * MiB, OFF_BIG = 47 * MiB;
constexpr size_t OFF_PR = OFF_BIG, OFF_Y = 191 * MiB, OFF_HN = 263 * MiB, OFF_PM = 335 * MiB;
constexpr size_t OFF_D4 = 263 * MiB, OFF_G = 407 * MiB, OFF_MRAW = 263 * MiB;
constexpr size_t OFF_GV = OFF_BIG, OFF_HN2 = 443 * MiB, WS_NEED = 507 * MiB;
constexpr size_t OFF_BAR = 900 * 1024;
#ifndef WGM_IN
#define WGM_IN 4
#endif
#ifndef WGM_OUT
#define WGM_OUT 4
#endif
#ifndef WGM_UP
#define WGM_UP 4
#endif
#ifndef WGM_DN
#define WGM_DN 4
#endif
constexpr int LDS_BYTES = 131072 + 256;

struct P { const float* in[33]; float* out; unsigned char* ws; };

typedef __bf16 bf16x2_t __attribute__((ext_vector_type(2)));
__device__ __forceinline__ unsigned cvt_pk_bf16(float lo, float hi) { const f32x2 v = {lo, hi}; const bf16x2_t b = __builtin_convertvector(v, bf16x2_t); return __builtin_bit_cast(unsigned, b); }
__device__ __forceinline__ float bflo(unsigned u) { return __uint_as_float(u << 16); }
__device__ __forceinline__ float bfhi(unsigned u) { return __uint_as_float(u & 0xffff0000u); }
__device__ __forceinline__ float bfe(const u32x4& v, int e) { unsigned w = v[e >> 1]; return (e & 1) ? bfhi(w) : bflo(w); }
__device__ __forceinline__ float bfe2(const u32x2& v, int e) { unsigned w = v[e >> 1]; return (e & 1) ? bfhi(w) : bflo(w); }
__device__ __forceinline__ float sigmoidf_(float x) { return __builtin_amdgcn_rcpf(1.f + __expf(-x)); }
__device__ __forceinline__ float siluf_(float x) { return x * __builtin_amdgcn_rcpf(1.f + __expf(-x)); }
__device__ __forceinline__ float tanhf_(float x) { return 1.f - 2.f * __builtin_amdgcn_rcpf(__expf(2.f * x) + 1.f); }
#define LDS_BARRIER() do { asm volatile("s_waitcnt lgkmcnt(0)" ::: "memory"); __builtin_amdgcn_s_barrier(); asm volatile("" ::: "memory"); } while (0)
__device__ __forceinline__ int opq_tid() { int t = threadIdx.x; asm volatile("" : "+v"(t)); return t; }
__device__ __forceinline__ int opq_bid() { int t = blockIdx.x; asm volatile("" : "+s"(t)); return t; }
__device__ __forceinline__ float wave_sum(float v) {
#pragma unroll
    for (int o = 1; o < 64; o <<= 1) v += __shfl_xor(v, o);
    return v;
}
#define DPP_ADD(v, ctrl) ((v) + __int_as_float(__builtin_amdgcn_update_dpp(0, __float_as_int(v), (ctrl), 0xf, 0xf, true)))
__device__ __forceinline__ float red8(float v) { v = DPP_ADD(v, 0xB1); v = DPP_ADD(v, 0x4E); v = DPP_ADD(v, 0x141); return v; }
__device__ __forceinline__ float red16(float v) { v = red8(v); v = DPP_ADD(v, 0x140); return v; }
__device__ __forceinline__ void grid_bar(unsigned* bar, unsigned& epoch, unsigned G) {
    asm volatile("s_waitcnt vmcnt(0)" ::: "memory");
    __syncthreads();
    ++epoch;
    if (threadIdx.x == 0) {
        __threadfence();
        asm volatile("s_waitcnt vmcnt(0)" ::: "memory");
        const unsigned old = __hip_atomic_fetch_add(bar, 1u, __ATOMIC_RELAXED, __HIP_MEMORY_SCOPE_AGENT);
        if (old + 1u == epoch * G) __hip_atomic_store(bar + 64, epoch, __ATOMIC_RELAXED, __HIP_MEMORY_SCOPE_AGENT);
        else while (__hip_atomic_load(bar + 64, __ATOMIC_RELAXED, __HIP_MEMORY_SCOPE_AGENT) < epoch) __builtin_amdgcn_s_sleep(1);
        __threadfence();
        asm volatile("s_waitcnt vmcnt(0)" ::: "memory");
    }
    __syncthreads();
}
#define XB_TMO      128
#define XB_XCNT(j)  (256  + 64 * (j))
#define XB_XSUB(j)  (1280 + 64 * (j))
#define XB_XGEN(j)  (2304 + 64 * (j))
#define XB_TOP      3328
#define XB_TOPGEN   3392
#define XCD_BAR_WORDS 3456
#define XB_SPIN_CAP (1u << 18)
__device__ __forceinline__ unsigned xb_ld(unsigned* p)              { return __hip_atomic_load(p, __ATOMIC_RELAXED, __HIP_MEMORY_SCOPE_AGENT); }
__device__ __forceinline__ unsigned xb_add(unsigned* p, unsigned v) { return __hip_atomic_fetch_add(p, v, __ATOMIC_RELAXED, __HIP_MEMORY_SCOPE_AGENT); }
__device__ __forceinline__ unsigned xb_xcc_id() { return (unsigned)__builtin_amdgcn_s_getreg((3 << 11) | 20) & 0xFu; }
#define XB_SPIN(cond, bar) do { unsigned _sp = 0; while (cond) { __builtin_amdgcn_s_sleep(1); \
    if ((++_sp & 255u) == 0u) { if (xb_ld(&(bar)[XB_TMO])) break; if (_sp > XB_SPIN_CAP) { atomicAdd(&(bar)[XB_TMO], 1u); break; } } } } while (0)
struct XcdBarrier { unsigned* bar; unsigned x; volatile LAS unsigned* st; };
__device__ __forceinline__ XcdBarrier xcd_barrier_post(unsigned* bar, volatile LAS unsigned* st) {
    XcdBarrier b; b.bar = bar; b.x = xb_xcc_id(); b.st = st;
    if (threadIdx.x == 0) (void)xb_add(&bar[XB_XCNT(b.x)], 1u);
    return b;
}
__device__ __forceinline__ void xcd_barrier_complete(unsigned* bar, unsigned x, unsigned& nloc, unsigned& nx) {
    const unsigned G = gridDim.x * gridDim.y * gridDim.z;
    unsigned sum, cnt, mine, sp = 0u;
    for (;;) {
        sum = 0u; cnt = 0u; mine = 0u;
#pragma unroll
        for (unsigned j = 0; j < 16; ++j) { const unsigned c = xb_ld(&bar[XB_XCNT(j)]); sum += c; cnt += (c > 0u) ? 1u : 0u; mine = (j == x) ? c : mine; }
        if (sum == G) break;
        __builtin_amdgcn_s_sleep(1);
        if ((++sp & 255u) == 0u) { if (xb_ld(&bar[XB_TMO])) break; if (sp > XB_SPIN_CAP) { atomicAdd(&bar[XB_TMO], 1u); break; } }
    }
    nloc = mine > 0u ? mine : 1u; nx = cnt > 0u ? cnt : 1u;
}
__device__ __forceinline__ void xcd_barrier(unsigned* bar_, volatile LAS unsigned* st_) {
    XcdBarrier b; b.bar = bar_; b.st = st_; b.x = 0u;
    asm volatile("s_waitcnt vmcnt(0)" ::: "memory");
    __syncthreads();
    if (threadIdx.x == 0) {
        unsigned* bar = b.bar; b.x = xb_xcc_id();
        __builtin_amdgcn_s_waitcnt(0);
        unsigned nloc = b.st[0], nx = b.st[1];
        if (nloc == 0u) { xcd_barrier_complete(bar, b.x, nloc, nx); b.st[0] = nloc; b.st[1] = nx; }
        const unsigned old = xb_add(&bar[XB_XSUB(b.x)], 1u);
        const unsigned gen = old / nloc;
        if (old + 1u == (gen + 1u) * nloc) {
            __builtin_amdgcn_fence(__ATOMIC_RELEASE, "agent");
            asm volatile("s_waitcnt vmcnt(0)" ::: "memory");
            const unsigned og = xb_add(&bar[XB_TOP], 1u);
            const unsigned tg = og / nx;
            if (og + 1u == (tg + 1u) * nx) xb_add(&bar[XB_TOPGEN], 1u);
            else XB_SPIN(xb_ld(&bar[XB_TOPGEN]) == tg, bar);
            __builtin_amdgcn_fence(__ATOMIC_ACQUIRE, "agent");
            xb_add(&bar[XB_XGEN(b.x)], 1u);
            asm volatile("s_waitcnt vmcnt(0)" ::: "memory");
        } else {
            XB_SPIN(xb_ld(&bar[XB_XGEN(b.x)]) == gen, bar);
            __builtin_amdgcn_fence(__ATOMIC_ACQUIRE, "agent");
            asm volatile("s_waitcnt vmcnt(0)" ::: "memory");
        }
    }
    __syncthreads();
}
__device__ __forceinline__ void row_info(int row, int& first, int& last, int& mrow) {
    if (row < RC) { int t = row & (CTX - 1); first = (t == 0); last = (t == CTX - 1); mrow = 16; }
    else { int rr = row - RC; int t = rr & (SEQ - 1); first = (t == 0); last = (t == SEQ - 1); mrow = rr >> 11; }
}
__device__ __forceinline__ void seqpos(int s, int dir, int b, int& row, int& first, int& last) {
    if (s < CTX) { int t = dir ? (CTX - 1 - s) : s; row = b * CTX + t; first = (t == 0); last = (t == CTX - 1); }
    else { int u = s - CTX; int t = dir ? (SEQ - 1 - u) : u; row = RC + b * SEQ + t; first = (t == 0); last = (t == SEQ - 1); }
}

namespace pg8 {
constexpr int BM = 256, BK = 64, HALF = 128, HTB = HALF * BK * 2, NXCD = 8;
__device__ __forceinline__ int lds_byte(int r, int c) { const int st = (r >> 4) * 2 + (c >> 5), rr = r & 15, cc = c & 31, ob = rr * 64 + cc * 2; return st * 1024 + (ob ^ (((ob >> 9) & 1) << 5)); }
__device__ __forceinline__ void stage_rc(int b, int& Rr, int& C) { const int st = b / 1024, sb = b % 1024, swz = sb ^ (((sb >> 9) & 1) << 5); Rr = (st >> 1) * 16 + swz / 64; C = (st & 1) * 32 + (swz % 64) / 2; }
__device__ __forceinline__ int perm32(int rho) { const int n = rho >> 4, i = rho & 15; return 8 * (i >> 2) + 4 * n + (i & 3); }
struct Unit { int pm, pn; };
struct Gemm { const bf16_t* A; const bf16_t* Bt; int M, N, K, lda; };
struct StaticOrder {
    int nM, nN, nwg, G, c, WGM;
    __device__ void init(int M, int N, int G_, int c_, int wgm_) { nM = M / BM; nN = N / BM; nwg = nM * nN; G = G_; c = c_; WGM = wgm_; }
    __device__ bool next(int i, Unit& u) const {
        const long L = (long)i * G + c; if (L >= nwg) return false;
        int wgid = (int)L; { const int q = nwg / NXCD, r = nwg % NXCD, xcd = wgid % NXCD, off = wgid / NXCD; wgid = (xcd < r ? xcd * (q + 1) : r * (q + 1) + (xcd - r) * q) + off; }
        const int nig = WGM * nN, gid = wgid / nig, fm = gid * WGM, gsz = (nM - fm) < WGM ? (nM - fm) : WGM;
        u.pm = fm + ((wgid % nig) % gsz); u.pn = (wgid % nig) / gsz; return true;
    }
};
struct EpiStore {
    bf16_t* O; int ldc;
    __device__ __forceinline__ void operator()(const f32x4 (&acc)[2][2][4][2], const Unit& u, int wr, int wc, int fr, int fq) const {
        const int row0 = u.pm * BM + wr * 64 + fr, col0 = u.pn * BM + wc * 32 + 8 * fq;
#pragma unroll
        for (int ai = 0; ai < 2; ++ai)
#pragma unroll
            for (int m = 0; m < 4; ++m) { bf16_t* rowp = O + (size_t)(row0 + ai * HALF + m * 16) * ldc + col0;
#pragma unroll
                for (int bj = 0; bj < 2; ++bj) { const f32x4 v0 = acc[ai][bj][m][0], v1 = acc[ai][bj][m][1];
                    u32x4 w; w.x = cvt_pk_bf16(v0[0], v0[1]); w.y = cvt_pk_bf16(v0[2], v0[3]); w.z = cvt_pk_bf16(v1[0], v1[1]); w.w = cvt_pk_bf16(v1[2], v1[3]);
                    *(u32x4*)(rowp + bj * HALF) = w; } }
    }
};
struct EpiInProj {
    bf16_t* PM; bf16_t* PR; float* DT;
    __device__ __forceinline__ void operator()(const f32x4 (&acc)[2][2][4][2], const Unit& u, int wr, int wc, int fr, int fq) const {
        const int row0 = u.pm * BM + wr * 64 + fr;
        bf16_t* base; int ldc, colt;
        if (u.pn < 6) { base = PM; ldc = PMW; colt = u.pn * BM; } else { base = PR; ldc = PRW; colt = (u.pn - 6) * BM; }
        const int col0 = colt + wc * 32 + 8 * fq;
        const bool isdt = (u.pn == 13) && (wc == 1) && (fq < 2);
#pragma unroll
        for (int ai = 0; ai < 2; ++ai)
#pragma unroll
            for (int m = 0; m < 4; ++m) { const int row = row0 + ai * HALF + m * 16; bf16_t* rowp = base + (size_t)row * ldc + col0;
#pragma unroll
                for (int bj = 0; bj < 2; ++bj) { const f32x4 v0 = acc[ai][bj][m][0], v1 = acc[ai][bj][m][1];
                    u32x4 w; w.x = cvt_pk_bf16(v0[0], v0[1]); w.y = cvt_pk_bf16(v0[2], v0[3]); w.z = cvt_pk_bf16(v1[0], v1[1]); w.w = cvt_pk_bf16(v1[2], v1[3]);
                    *(u32x4*)(rowp + bj * HALF) = w; }
                if (isdt) { float* d = DT + (size_t)row * 16 + fq * 8; *(f32x4*)d = acc[ai][1][m][0]; *(f32x4*)(d + 4) = acc[ai][1][m][1]; } }
    }
};

template <class Epi>
__device__ __forceinline__ void gemm_phase(LAS unsigned char* lds, const Gemm g, const StaticOrder& S, const Epi& E) {
    const int tid = opq_tid(), wid = __builtin_amdgcn_readfirstlane(tid >> 6), lane = tid & 63, wr = wid >> 2, wc = wid & 3, fr = lane & 15, fq = lane >> 4;
    const int K = g.K, nt = K / BK, lda = g.lda;
    unsigned voffA[2], voffB[2];
#pragma unroll
    for (int i = 0; i < 2; ++i) { int Rr, C; stage_rc(tid * 16 + i * 8192, Rr, C); const int Rb = (Rr & ~31) + perm32(Rr & 31);
        voffA[i] = (unsigned)(Rr * lda + C) * 2u; voffB[i] = (unsigned)(Rb * K + C) * 2u; }
    const size_t kstep = (size_t)(BK * 2);
    const size_t hsA = (size_t)HALF * lda * 2, hsB = (size_t)HALF * K * 2;
    const size_t tsA = 2 * hsA, tsB = 2 * hsB;
    const unsigned ldsw = (unsigned)wid * 1024u;
    const int aoff = lds_byte(wr * 64 + fr, fq * 8), boff = lds_byte(wc * 32 + fr, fq * 8);
#define PG8_SA(b, h) (((b) * 2 + (h)) * HTB)
#define PG8_SB(b, h) ((4 + (b) * 2 + (h)) * HTB)
#define PG8_STAGE(bufoff, gbase, voff) do { _Pragma("unroll") for (int _i = 0; _i < 2; ++_i) \
        __builtin_amdgcn_global_load_lds((const unsigned*)((const char*)(gbase) + (voff)[_i]), (LAS unsigned*)(lds + (bufoff) + ldsw + _i * 8192), 16, 0, 0); } while (0)
#define PG8_LDA(dst, b, h) do { _Pragma("unroll") for (int m = 0; m < 4; ++m) _Pragma("unroll") for (int k = 0; k < 2; ++k) dst[m][k] = *(const LAS bf16x8*)(lds + PG8_SA(b, h) + aoff + m * 2048 + k * 1024); } while (0)
#define PG8_LDB(dst, b, h) do { _Pragma("unroll") for (int n = 0; n < 2; ++n) _Pragma("unroll") for (int k = 0; k < 2; ++k) dst[n][k] = *(const LAS bf16x8*)(lds + PG8_SB(b, h) + boff + n * 2048 + k * 1024); } while (0)
#define PG8_MMA(ai, bj, At, Bt) do { __builtin_amdgcn_s_setprio(1); _Pragma("unroll") for (int m = 0; m < 4; ++m) _Pragma("unroll") for (int n = 0; n < 2; ++n) _Pragma("unroll") for (int k = 0; k < 2; ++k) \
        acc[ai][bj][m][n] = __builtin_amdgcn_mfma_f32_16x16x32_bf16(Bt[n][k], At[m][k], acc[ai][bj][m][n], 0, 0, 0); __builtin_amdgcn_s_setprio(0); } while (0)
#define PG8_WAIT_V(n) asm volatile("s_waitcnt vmcnt(" #n ")" ::: "memory")
#define PG8_WAIT_L(n) asm volatile("s_waitcnt lgkmcnt(" #n ")" ::: "memory")
#define PG8_BAR __builtin_amdgcn_s_barrier()
#define PG8_SCHED __builtin_amdgcn_sched_barrier(0)
    Unit cur, nxt; int ui = 0;
    if (!S.next(0, cur)) return;
    f32x4 acc[2][2][4][2];
#pragma unroll
    for (int a = 0; a < 2; ++a)
#pragma unroll
        for (int b = 0; b < 2; ++b)
#pragma unroll
            for (int m = 0; m < 4; ++m)
#pragma unroll
                for (int n = 0; n < 2; ++n) acc[a][b][m][n] = (f32x4){0.f, 0.f, 0.f, 0.f};
    bf16x8 At[4][2], B0[2][2], B1[2][2];
    const char* cA = (const char*)g.A + (size_t)cur.pm * tsA; const char* cB = (const char*)g.Bt + (size_t)cur.pn * tsB;
    PG8_STAGE(PG8_SB(0, 0), cB, voffB); PG8_STAGE(PG8_SB(0, 1), cB + hsB, voffB); PG8_STAGE(PG8_SA(0, 0), cA, voffA); PG8_STAGE(PG8_SA(0, 1), cA + hsA, voffA);
    if (wr == 1) PG8_BAR;
    PG8_WAIT_V(2); PG8_BAR;
    PG8_STAGE(PG8_SB(1, 0), cB + kstep, voffB); PG8_STAGE(PG8_SA(1, 0), cA + kstep, voffA); PG8_STAGE(PG8_SB(1, 1), cB + hsB + kstep, voffB);
    PG8_WAIT_V(6); PG8_BAR;
    for (;;) {
        const bool has_next = S.next(ui + 1, nxt);
        const char* nA = has_next ? (const char*)g.A + (size_t)nxt.pm * tsA : cA; const char* nB = has_next ? (const char*)g.Bt + (size_t)nxt.pn * tsB : cB;
        for (int t = 0; t < nt; t += 2) {
            const bool last = (t == nt - 2);
            const char* a1 = cA + (size_t)(t + 1) * kstep;
            const char* a2 = last ? nA : cA + (size_t)(t + 2) * kstep; const char* b2 = last ? nB : cB + (size_t)(t + 2) * kstep;
            const char* a3 = a2 + kstep; const char* b3 = b2 + kstep;
            PG8_LDB(B0, 0, 0); PG8_LDB(B1, 0, 1); PG8_SCHED; PG8_LDA(At, 0, 0); PG8_STAGE(PG8_SA(1, 1), a1 + hsA, voffA);
            PG8_WAIT_V(8); PG8_WAIT_L(0); PG8_BAR; PG8_MMA(0, 0, At, B0); PG8_MMA(0, 1, At, B1); PG8_BAR; PG8_SCHED;
            PG8_LDA(At, 0, 1); PG8_STAGE(PG8_SB(0, 0), b2, voffB); PG8_STAGE(PG8_SB(0, 1), b2 + hsB, voffB); PG8_STAGE(PG8_SA(0, 0), a2, voffA);
            PG8_WAIT_V(8); PG8_WAIT_L(0); PG8_BAR; PG8_MMA(1, 0, At, B0); PG8_MMA(1, 1, At, B1); PG8_BAR; PG8_SCHED;
            PG8_LDB(B0, 1, 0); PG8_LDB(B1, 1, 1); PG8_SCHED; PG8_LDA(At, 1, 0); PG8_STAGE(PG8_SA(0, 1), a2 + hsA, voffA);
            PG8_WAIT_V(8); PG8_WAIT_L(0); PG8_BAR; PG8_MMA(0, 0, At, B0); PG8_MMA(0, 1, At, B1); PG8_BAR; PG8_SCHED;
            PG8_LDA(At, 1, 1); PG8_STAGE(PG8_SB(1, 0), b3, voffB); PG8_STAGE(PG8_SB(1, 1), b3 + hsB, voffB); PG8_STAGE(PG8_SA(1, 0), a3, voffA);
            PG8_WAIT_V(8); PG8_WAIT_L(0); PG8_BAR; PG8_MMA(1, 0, At, B0); PG8_MMA(1, 1, At, B1); PG8_BAR; PG8_SCHED;
        }
        if (wr == 0) PG8_BAR;
        E(acc, cur, wr, wc, fr, fq);
        if (!has_next) break;
#pragma unroll
        for (int a = 0; a < 2; ++a)
#pragma unroll
            for (int b = 0; b < 2; ++b)
#pragma unroll
                for (int m = 0; m < 4; ++m)
#pragma unroll
                    for (int n = 0; n < 2; ++n) acc[a][b][m][n] = (f32x4){0.f, 0.f, 0.f, 0.f};
        cur = nxt; cA = nA; cB = nB; ++ui;
        if (wr == 1) PG8_BAR;
    }
    PG8_WAIT_V(0);
    PG8_BAR;
#undef PG8_SA
#undef PG8_SB
#undef PG8_STAGE
#undef PG8_LDA
#undef PG8_LDB
#undef PG8_MMA
#undef PG8_WAIT_V
#undef PG8_WAIT_L
#undef PG8_BAR
#undef PG8_SCHED
}
}

__device__ __forceinline__ int win_colmap(int j) { return j < 1536 ? j : (j < 3488 ? j + 16 : (j < 3504 ? j - 1952 : -1)); }
template <bool WIN>
__device__ __forceinline__ void transpose_tile(LAS float* tile, const float* W, int K, int N, bf16_t* WT, int item, int ntn) {
    const int tid = opq_tid(), n0 = (item % ntn) * 64, k0 = (item / ntn) * 64;
    const int tx = tid & 63, ty = tid >> 6;
    int col = n0 + tx; if (WIN) col = win_colmap(col);
#pragma unroll
    for (int i = 0; i < 8; ++i) { const int kk = ty + i * 8; tile[kk * 65 + tx] = (col >= 0) ? W[(size_t)(k0 + kk) * N + col] : 0.f; }
    __syncthreads();
    const int n = tid >> 3, ks = (tid & 7) * 8;
    u32x4 o; o.x = cvt_pk_bf16(tile[(ks + 0) * 65 + n], tile[(ks + 1) * 65 + n]); o.y = cvt_pk_bf16(tile[(ks + 2) * 65 + n], tile[(ks + 3) * 65 + n]);
    o.z = cvt_pk_bf16(tile[(ks + 4) * 65 + n], tile[(ks + 5) * 65 + n]); o.w = cvt_pk_bf16(tile[(ks + 6) * 65 + n], tile[(ks + 7) * 65 + n]);
    *(u32x4*)(WT + (size_t)(n0 + n) * K + k0 + ks) = o;
    __syncthreads();
}
__device__ __forceinline__ void convert_weights(LAS unsigned char* lds, const P& p, int l) {
    LAS float* tile = (LAS float*)lds;
    unsigned char* ws = p.ws;
    constexpr int I_IN = (NIN / 64) * (DM / 64), I_OUT = 16 * 16, I_UP = (NUP / 64) * 16, I_DN = 16 * (DFF / 64);
    for (int it = opq_bid(); it < I_IN + I_OUT + I_UP + I_DN; it += gridDim.x) {
        int r = it;
        if (r < I_IN) { transpose_tile<true>(tile, p.in[10] + (size_t)l * DM * 3504, DM, 3504, (bf16_t*)(ws + OFF_WIN), r, NIN / 64); continue; } r -= I_IN;
        if (r < I_OUT) { transpose_tile<false>(tile, p.in[11] + (size_t)l * DM * DM, DM, DM, (bf16_t*)(ws + OFF_WOUT), r, 16); continue; } r -= I_OUT;
        if (r < I_UP) { transpose_tile<false>(tile, p.in[29] + (size_t)l * DM * NUP, DM, NUP, (bf16_t*)(ws + OFF_WUP), r, NUP / 64); continue; } r -= I_UP;
        transpose_tile<false>(tile, p.in[32] + (size_t)l * DFF * DM, DFF, DM, (bf16_t*)(ws + OFF_WDN), r, 16);
    }
    bf16_t* W2t = (bf16_t*)(ws + OFF_LORA); bf16_t* A2t = W2t + 2 * 512 * 64; bf16_t* G2t = A2t + 2 * 512 * 64;
    const int gt = opq_bid() * 512 + opq_tid(), gs = gridDim.x * 512;
    for (int i = gt; i < 2 * 512 * 64; i += gs) { const int d = i >> 15, n = (i >> 6) & 511, k = i & 63;
        W2t[i] = (bf16_t)(cvt_pk_bf16(p.in[20][((size_t)(l * 2 + d) * 64 + k) * 512 + n], 0.f) & 0xffffu);
        A2t[i] = (bf16_t)(cvt_pk_bf16(p.in[22][((size_t)(l * 2 + d) * 64 + k) * 512 + n], 0.f) & 0xffffu); }
    for (int i = gt; i < 512 * 160; i += gs) { const int n = i / 160, k = i % 160;
        G2t[i] = (bf16_t)(cvt_pk_bf16(p.in[23][((size_t)l * 160 + k) * 512 + n], 0.f) & 0xffffu); }
}

__device__ __forceinline__ void mod_phase(LAS unsigned char* lds, const P& p) {
    LAS float* sil = (LAS float*)lds;
    LAS float* red = sil + 17 * 1024;
    const int tid = opq_tid();
    float* mod = (float*)(p.ws + OFF_MOD);
    if ((int)opq_bid() >= 384) return;
    __syncthreads();
    for (int i = tid; i < 17 * 1024; i += 512) { const int r = i >> 10, k = i & 1023; const float v = (r < 16) ? p.in[1][r * 1024 + k] : p.in[3][k]; sil[i] = siluf_(v); }
    __syncthreads();
    for (int item = opq_bid(); item < 384; item += gridDim.x) {
        const int l = item / 192, cb = item % 192, cc = tid & 31, kg = tid >> 5, col = cb * 32 + cc;
        float acc[17];
#pragma unroll
        for (int r = 0; r < 17; ++r) acc[r] = 0.f;
        const float* wp = p.in[4] + ((size_t)l * 1024 + kg * 64) * 6144 + col;
#pragma unroll 4
        for (int kk = 0; kk < 64; ++kk) { const float w = wp[(size_t)kk * 6144]; const int k = kg * 64 + kk;
#pragma unroll
            for (int r = 0; r < 17; ++r) acc[r] += sil[r * 1024 + k] * w; }
#pragma unroll
        for (int r = 0; r < 17; ++r) red[(kg * 17 + r) * 32 + cc] = acc[r];
        __syncthreads();
        for (int idx = tid; idx < 17 * 32; idx += 512) { const int r = idx >> 5, c2 = idx & 31; float s = p.in[5][l * 6144 + cb * 32 + c2];
            for (int k2 = 0; k2 < 16; ++k2) s += red[(k2 * 17 + r) * 32 + c2];
            mod[(size_t)(l * 17 + r) * 6144 + cb * 32 + c2] = s; }
        __syncthreads();
    }
}

template <bool POST, bool NORM>
__device__ __forceinline__ void row_phase(const P& p, int l, int lN, int r0, int r1,
                                          const float* xlat, const float* xctx,
                                          const bf16_t* M, int ldm, int mbase,
                                          const float* gpost, int gateoff,
                                          float* olat, float* octx,
                                          const float* gpre, int shoff,
                                          bf16_t* HN, int hbase) {
    const int lane = opq_tid() & 63, wid = opq_tid() >> 6;
    const float* mod = (const float*)(p.ws + OFF_MOD);
    const int npair = (r1 - r0) >> 1, pend = npair, pstep = (int)gridDim.x * 8;
    f32x4 gt[4], sh[4], sc[4];
    int curm = -1;
    f32x4 xA[2][4], xB[2][4]; u32x2 mA[2][4], mB[2][4];
#define RP_LOAD(X, pr_) do { const int rowb_ = r0 + (pr_) * 2; const bool isc_ = rowb_ < RC; \
        const float* xr_ = isc_ ? xctx + (size_t)rowb_ * DM : xlat + (size_t)(rowb_ - RC) * DM; \
        _Pragma("unroll") for (int u = 0; u < 2; ++u) _Pragma("unroll") for (int i = 0; i < 4; ++i) x##X[u][i] = *(const f32x4*)(xr_ + u * DM + i * 256 + lane * 4); \
        if (POST) { const bf16_t* mr_ = M + (size_t)(rowb_ - mbase) * ldm; \
            _Pragma("unroll") for (int u = 0; u < 2; ++u) _Pragma("unroll") for (int i = 0; i < 4; ++i) m##X[u][i] = *(const u32x2*)(mr_ + (size_t)u * ldm + i * 256 + lane * 4); } } while (0)
#define RP_COMPUTE(X, pr_) do { const int rowb = r0 + (pr_) * 2; const bool isc = rowb < RC; const int mrow = isc ? 16 : ((rowb - RC) >> 11); \
        if (mrow != curm) { curm = mrow; \
            _Pragma("unroll") for (int i = 0; i < 4; ++i) { const int c = i * 256 + lane * 4; \
                if (POST) gt[i] = *(const f32x4*)(mod + (size_t)(l * 17 + mrow) * 6144 + gateoff + c); \
                if (NORM) { sh[i] = *(const f32x4*)(mod + (size_t)(lN * 17 + mrow) * 6144 + shoff + c); sc[i] = *(const f32x4*)(mod + (size_t)(lN * 17 + mrow) * 6144 + shoff + 1024 + c); } } } \
        if (POST) { float ss0 = 0.f, ss1 = 0.f; f32x4 mv[2][4]; \
            _Pragma("unroll") for (int i = 0; i < 4; ++i) { \
                const u32x2 w0 = m##X[0][i], w1 = m##X[1][i]; \
                mv[0][i] = (f32x4){bflo(w0.x), bfhi(w0.x), bflo(w0.y), bfhi(w0.y)}; mv[1][i] = (f32x4){bflo(w1.x), bfhi(w1.x), bflo(w1.y), bfhi(w1.y)}; \
                ss0 += mv[0][i][0] * mv[0][i][0] + mv[0][i][1] * mv[0][i][1] + mv[0][i][2] * mv[0][i][2] + mv[0][i][3] * mv[0][i][3]; \
                ss1 += mv[1][i][0] * mv[1][i][0] + mv[1][i][1] * mv[1][i][1] + mv[1][i][2] * mv[1][i][2] + mv[1][i][3] * mv[1][i][3]; } \
            const float rs0 = rsqrtf(wave_sum(ss0) * (1.f / DM) + EPS), rs1 = rsqrtf(wave_sum(ss1) * (1.f / DM) + EPS); \
            float* orow = isc ? octx + (size_t)rowb * DM : olat + (size_t)(rowb - RC) * DM; \
            _Pragma("unroll") for (int i = 0; i < 4; ++i) { const int c = i * 256 + lane * 4; \
                const f32x4 gpi = *(const f32x4*)(gpost + c); \
                x##X[0][i] = x##X[0][i] + gt[i] * (mv[0][i] * rs0 * gpi); x##X[1][i] = x##X[1][i] + gt[i] * (mv[1][i] * rs1 * gpi); \
                *(f32x4*)(orow + c) = x##X[0][i]; *(f32x4*)(orow + DM + c) = x##X[1][i]; } } \
        if (NORM) { float ss0 = 0.f, ss1 = 0.f; \
            _Pragma("unroll") for (int i = 0; i < 4; ++i) { \
                ss0 += x##X[0][i][0] * x##X[0][i][0] + x##X[0][i][1] * x##X[0][i][1] + x##X[0][i][2] * x##X[0][i][2] + x##X[0][i][3] * x##X[0][i][3]; \
                ss1 += x##X[1][i][0] * x##X[1][i][0] + x##X[1][i][1] * x##X[1][i][1] + x##X[1][i][2] * x##X[1][i][2] + x##X[1][i][3] * x##X[1][i][3]; } \
            const float rs0 = rsqrtf(wave_sum(ss0) * (1.f / DM) + EPS), rs1 = rsqrtf(wave_sum(ss1) * (1.f / DM) + EPS); \
            bf16_t* hr = HN + (size_t)(rowb - hbase) * DM; \
            _Pragma("unroll") for (int i = 0; i < 4; ++i) { const int c = i * 256 + lane * 4; \
                const f32x4 g4i = *(const f32x4*)(gpre + c); \
                const f32x4 y0 = (x##X[0][i] * rs0 * g4i) * (sc[i] + 1.f) + sh[i], y1 = (x##X[1][i] * rs1 * g4i) * (sc[i] + 1.f) + sh[i]; \
                u32x2 o; o.x = cvt_pk_bf16(y0[0], y0[1]); o.y = cvt_pk_bf16(y0[2], y0[3]); *(u32x2*)(hr + c) = o; \
                o.x = cvt_pk_bf16(y1[0], y1[1]); o.y = cvt_pk_bf16(y1[2], y1[3]); *(u32x2*)(hr + DM + c) = o; } } } while (0)
    int pr = opq_bid() * 8 + wid;
    if (pr < pend) RP_LOAD(A, pr);
    while (pr < pend) {
        int pn = pr + pstep;
        if (pn < pend) RP_LOAD(B, pn);
        __builtin_amdgcn_sched_barrier(0);
        RP_COMPUTE(A, pr);
        __builtin_amdgcn_sched_barrier(0);
        pr = pn; if (pr >= pend) break;
        pn = pr + pstep;
        if (pn < pend) RP_LOAD(A, pn);
        __builtin_amdgcn_sched_barrier(0);
        RP_COMPUTE(B, pr);
        __builtin_amdgcn_sched_barrier(0);
        pr = pn;
    }
#undef RP_LOAD
#undef RP_COMPUTE
}

__device__ __forceinline__ void xbc_phase(const P& p, int l) {
    const bf16_t* PM = (const bf16_t*)(p.ws + OFF_PM);
    bf16_t* XBC = (bf16_t*)(p.ws + OFF_HN);
    const float* cw = p.in[12] + (size_t)l * 3 * 1024; const float* cb = p.in[13] + (size_t)l * 1024;
    const int idx0 = opq_bid() * 512 + opq_tid(), istep = (int)gridDim.x * 512, c8 = (idx0 & 127) * 8;
    f32x4 w0[2], w1[2], w2[2], bb[2];
#pragma unroll
    for (int hh = 0; hh < 2; ++hh) { w0[hh] = *(const f32x4*)(cw + c8 + hh * 4); w1[hh] = *(const f32x4*)(cw + 1024 + c8 + hh * 4); w2[hh] = *(const f32x4*)(cw + 2048 + c8 + hh * 4); bb[hh] = *(const f32x4*)(cb + c8 + hh * 4); }
    const u32x4 z4 = (u32x4){0u, 0u, 0u, 0u};
    u32x4 xcA, xpA, xnA, xcB, xpB, xnB; int flA = 0, flB = 0;
#define XQ_LOAD(X, idx_) do { const int row_ = (idx_) >> 7; int f_, l_, m_; row_info(row_, f_, l_, m_); const bf16_t* src = PM + (size_t)row_ * PMW + 512 + c8; \
        xc##X = *(const u32x4*)src; xp##X = *(const u32x4*)(src - (f_ ? 0 : PMW)); xn##X = *(const u32x4*)(src + (l_ ? 0 : PMW)); fl##X = f_ | (l_ << 1); } while (0)
#define XQ_COMPUTE(X, idx_) do { float o[8]; const u32x4 xp_ = (fl##X & 1) ? z4 : xp##X, xn_ = (fl##X & 2) ? z4 : xn##X; \
        _Pragma("unroll") for (int hh = 0; hh < 2; ++hh) _Pragma("unroll") for (int e = 0; e < 4; ++e) \
            o[hh * 4 + e] = siluf_(w0[hh][e] * bfe(xp_, hh * 4 + e) + w1[hh][e] * bfe(xc##X, hh * 4 + e) + w2[hh][e] * bfe(xn_, hh * 4 + e) + bb[hh][e]); \
        u32x4 w; w.x = cvt_pk_bf16(o[0], o[1]); w.y = cvt_pk_bf16(o[2], o[3]); w.z = cvt_pk_bf16(o[4], o[5]); w.w = cvt_pk_bf16(o[6], o[7]); \
        *(u32x4*)(XBC + (size_t)((idx_) >> 7) * 1024 + c8) = w; } while (0)
    const int iend = R * 128;
    int idx = idx0;
    if ((istep & 127) != 0) {
        for (; idx < iend; idx += istep) { const int row = idx >> 7, cc = (idx & 127) * 8; int first, last, mrow; row_info(row, first, last, mrow);
            const bf16_t* src = PM + (size_t)row * PMW + 512 + cc;
            const u32x4 xc = *(const u32x4*)src, xp = first ? z4 : *(const u32x4*)(src - PMW), xn = last ? z4 : *(const u32x4*)(src + PMW);
            float o[8];
#pragma unroll
            for (int e = 0; e < 8; ++e) o[e] = siluf_(cw[cc + e] * bfe(xp, e) + cw[1024 + cc + e] * bfe(xc, e) + cw[2048 + cc + e] * bfe(xn, e) + cb[cc + e]);
            u32x4 w; w.x = cvt_pk_bf16(o[0], o[1]); w.y = cvt_pk_bf16(o[2], o[3]); w.z = cvt_pk_bf16(o[4], o[5]); w.w = cvt_pk_bf16(o[6], o[7]);
            *(u32x4*)(XBC + (size_t)row * 1024 + cc) = w; }
        return;
    }
    if (idx < iend) XQ_LOAD(A, idx);
    while (idx < iend) {
        int in_ = idx + istep;
        if (in_ < iend) XQ_LOAD(B, in_);
        __builtin_amdgcn_sched_barrier(0);
        XQ_COMPUTE(A, idx);
        __builtin_amdgcn_sched_barrier(0);
        idx = in_; if (idx >= iend) break;
        in_ = idx + istep;
        if (in_ < iend) XQ_LOAD(A, in_);
        __builtin_amdgcn_sched_barrier(0);
        XQ_COMPUTE(B, idx);
        __builtin_amdgcn_sched_barrier(0);
        idx = in_;
    }
#undef XQ_LOAD
#undef XQ_COMPUTE
}

__device__ __forceinline__ void mamba_chunk_phase(LAS unsigned char* lds, const P& p, int l) {
    constexpr int Q = 64, NCH = (CTX + SEQ) / Q, SX = 72, SB = 136;
    LAS bf16_t* XT = (LAS bf16_t*)lds;
    LAS bf16_t* XsT = XT + 64 * SX;
    LAS bf16_t* Mm = XsT + 64 * SX;
    LAS bf16_t* BT = Mm + 64 * SX;
    LAS bf16_t* Bm = BT + 128 * SX;
    LAS bf16_t* Cm = Bm + 64 * SB;
    LAS bf16_t* Hb = Cm + 64 * SB;
    LAS float* fab = (LAS float*)(Hb + 64 * SB);
    const int tid = opq_tid(), lane = tid & 63, w = tid >> 6, fr = lane & 15, fq = lane >> 4;
    const bf16_t* XBC = (const bf16_t*)(p.ws + OFF_HN);
    const float* DT = (const float*)(p.ws + OFF_DT);
    bf16_t* Y = (bf16_t*)(p.ws + OFF_Y);
    for (int q = opq_bid(); q < 256; q += gridDim.x) {
        const int b = q >> 4, h = (q >> 1) & 7, dir = q & 1, g = h >> 2;
        const float dtb = p.in[14][l * 16 + dir * 8 + h];
        const float Aneg = -expf(p.in[15][l * 16 + dir * 8 + h]);
        f32x4 Hacc[4];
#pragma unroll
        for (int i = 0; i < 4; ++i) Hacc[i] = (f32x4){0.f, 0.f, 0.f, 0.f};
        u32x4 pre[5]; float dtraw = 0.f;
#define C_ISSUE(ci) do { int row, first, last; seqpos((ci) * Q + lane, dir, b, row, first, last); const bf16_t* rp = XBC + (size_t)row * 1024; \
            _Pragma("unroll") for (int i = 0; i < 5; ++i) { const int pc = w + 8 * i; \
                const int col = pc < 8 ? h * 64 + pc * 8 : (pc < 24 ? 512 + g * 128 + (pc - 8) * 8 : 768 + g * 128 + (pc - 24) * 8); \
                pre[i] = *(const u32x4*)(rp + col); } \
            if (tid < Q) dtraw = DT[(size_t)row * 16 + dir * 8 + h]; } while (0)
#define C_STORE() do { const int j = lane; _Pragma("unroll") for (int i = 0; i < 5; ++i) { const int pc = w + 8 * i; const u32x4 v = pre[i]; \
            if (pc < 8) { _Pragma("unroll") for (int e = 0; e < 8; ++e) XT[(pc * 8 + e) * SX + j] = (bf16_t)((e & 1) ? (v[e >> 1] >> 16) : (v[e >> 1] & 0xffffu)); } \
            else if (pc < 24) { const int n0 = (pc - 8) * 8; *(LAS u32x4*)(Bm + j * SB + n0) = v; \
                _Pragma("unroll") for (int e = 0; e < 8; ++e) BT[(n0 + e) * SX + j] = (bf16_t)((e & 1) ? (v[e >> 1] >> 16) : (v[e >> 1] & 0xffffu)); } \
            else { const int n0 = (pc - 24) * 8; *(LAS u32x4*)(Cm + j * SB + n0) = v; } } } while (0)
        __syncthreads();
        for (int i = tid; i < 64 * SB / 2; i += 512) ((LAS unsigned*)Hb)[i] = 0u;
        C_ISSUE(0); C_STORE();
        float dtcur = dtraw;
        if (w == 0) { LAS float* faw = fab;
                const float xx = dtcur + dtb; const float dt = xx > 20.f ? xx : log1pf(__expf(xx));
                float a = dt * Aneg;
                a = DPP_ADD(a, 0x111); a = DPP_ADD(a, 0x112); a = DPP_ADD(a, 0x114); a = DPP_ADD(a, 0x118);
                const float t15 = __int_as_float(__builtin_amdgcn_readlane(__float_as_int(a), 15));
                const float t31 = __int_as_float(__builtin_amdgcn_readlane(__float_as_int(a), 31));
                const float t47 = __int_as_float(__builtin_amdgcn_readlane(__float_as_int(a), 47));
                a += (lane >= 48) ? (t15 + t31 + t47) : (lane >= 32 ? (t15 + t31) : (lane >= 16 ? t15 : 0.f));
                const float cl = __int_as_float(__builtin_amdgcn_readlane(__float_as_int(a), 63));
                faw[lane] = a; faw[64 + lane] = __expf(a); faw[128 + lane] = __expf(cl - a) * dt; faw[192 + lane] = dt;
        }
        __syncthreads();
        for (int ci = 0; ci < NCH; ++ci) {
            if (ci + 1 < NCH) C_ISSUE(ci + 1);
            LAS float* fa = fab + (ci & 1) * 256;
            __builtin_amdgcn_s_setprio(1);
            { const int ti = w >> 1, tj0 = (w & 1) * 2;
              f32x4 gacc[2] = {(f32x4){0.f, 0.f, 0.f, 0.f}, (f32x4){0.f, 0.f, 0.f, 0.f}};
#pragma unroll
              for (int kk = 0; kk < 4; ++kk) { const bf16x8 cf = *(const LAS bf16x8*)(Cm + (ti * 16 + fr) * SB + kk * 32 + fq * 8);
#pragma unroll
                  for (int t = 0; t < 2; ++t) { const bf16x8 bfg = *(const LAS bf16x8*)(Bm + ((tj0 + t) * 16 + fr) * SB + kk * 32 + fq * 8);
                      gacc[t] = __builtin_amdgcn_mfma_f32_16x16x32_bf16(bfg, cf, gacc[t], 0, 0, 0); } }
              const int i = ti * 16 + fr; const float cmi = fa[i];
#pragma unroll
              for (int t = 0; t < 2; ++t) { const int j0 = (tj0 + t) * 16 + fq * 4; float m[4];
                  const f32x4 cj4 = *(const LAS f32x4*)(fa + j0), dj4 = *(const LAS f32x4*)(fa + 192 + j0);
#pragma unroll
                  for (int jj = 0; jj < 4; ++jj) { const int j = j0 + jj; const float lv = __expf(fminf(cmi - cj4[jj], 0.f)) * dj4[jj]; m[jj] = (j <= i) ? gacc[t][jj] * lv : 0.f; }
                  u32x2 o; o.x = cvt_pk_bf16(m[0], m[1]); o.y = cvt_pk_bf16(m[2], m[3]);
                  *(LAS u32x2*)(Mm + i * SX + j0) = o; } }
            __builtin_amdgcn_s_setprio(0);
            { const int pq = tid >> 3, j8 = (tid & 7) * 8; const u32x4 v = *(const LAS u32x4*)(XT + pq * SX + j8);
              const f32x4 wa = *(const LAS f32x4*)(fa + 128 + j8), wb = *(const LAS f32x4*)(fa + 128 + j8 + 4);
              u32x4 o; o.x = cvt_pk_bf16(bflo(v.x) * wa[0], bfhi(v.x) * wa[1]); o.y = cvt_pk_bf16(bflo(v.y) * wa[2], bfhi(v.y) * wa[3]);
              o.z = cvt_pk_bf16(bflo(v.z) * wb[0], bfhi(v.z) * wb[1]); o.w = cvt_pk_bf16(bflo(v.w) * wb[2], bfhi(v.w) * wb[3]);
              *(LAS u32x4*)(XsT + pq * SX + j8) = o; }
            LDS_BARRIER();
            __builtin_amdgcn_s_setprio(1);
            { const int tp = w >> 1, ti0 = (w & 1) * 2;
              f32x4 a1[2] = {(f32x4){0.f, 0.f, 0.f, 0.f}, (f32x4){0.f, 0.f, 0.f, 0.f}}, a2[2] = {(f32x4){0.f, 0.f, 0.f, 0.f}, (f32x4){0.f, 0.f, 0.f, 0.f}};
#pragma unroll
              for (int kk = 0; kk < 2; ++kk) { const bf16x8 af = *(const LAS bf16x8*)(XT + (tp * 16 + fr) * SX + kk * 32 + fq * 8);
#pragma unroll
                  for (int t = 0; t < 2; ++t) { const bf16x8 mf = *(const LAS bf16x8*)(Mm + ((ti0 + t) * 16 + fr) * SX + kk * 32 + fq * 8);
                      a1[t] = __builtin_amdgcn_mfma_f32_16x16x32_bf16(af, mf, a1[t], 0, 0, 0); } }
#pragma unroll
              for (int kk = 0; kk < 4; ++kk) { const bf16x8 hf = *(const LAS bf16x8*)(Hb + (tp * 16 + fr) * SB + kk * 32 + fq * 8);
#pragma unroll
                  for (int t = 0; t < 2; ++t) { const bf16x8 cf = *(const LAS bf16x8*)(Cm + ((ti0 + t) * 16 + fr) * SB + kk * 32 + fq * 8);
                      a2[t] = __builtin_amdgcn_mfma_f32_16x16x32_bf16(hf, cf, a2[t], 0, 0, 0); } }
#pragma unroll
              for (int t = 0; t < 2; ++t) { const int i = (ti0 + t) * 16 + fr; const float ei = fa[64 + i];
                  int row, first, last; seqpos(ci * Q + i, dir, b, row, first, last);
                  const f32x4 yv = a1[t] + a2[t] * ei;
                  u32x2 o; o.x = cvt_pk_bf16(yv[0], yv[1]); o.y = cvt_pk_bf16(yv[2], yv[3]);
                  *(u32x2*)(Y + (size_t)row * DM + dir * 512 + h * 64 + tp * 16 + fq * 4) = o; } }
            if (w == 0 && ci + 1 < NCH) { LAS float* faw = fab + ((ci + 1) & 1) * 256;
                const float xx = dtraw + dtb; const float dt = xx > 20.f ? xx : log1pf(__expf(xx));
                float a = dt * Aneg;
                a = DPP_ADD(a, 0x111); a = DPP_ADD(a, 0x112); a = DPP_ADD(a, 0x114); a = DPP_ADD(a, 0x118);
                const float t15 = __int_as_float(__builtin_amdgcn_readlane(__float_as_int(a), 15));
                const float t31 = __int_as_float(__builtin_amdgcn_readlane(__float_as_int(a), 31));
                const float t47 = __int_as_float(__builtin_amdgcn_readlane(__float_as_int(a), 47));
                a += (lane >= 48) ? (t15 + t31 + t47) : (lane >= 32 ? (t15 + t31) : (lane >= 16 ? t15 : 0.f));
                const float cl = __int_as_float(__builtin_amdgcn_readlane(__float_as_int(a), 63));
                faw[lane] = a; faw[64 + lane] = __expf(a); faw[128 + lane] = __expf(cl - a) * dt; faw[192 + lane] = dt;
            }
            { const float decl = fa[64 + 63];
#pragma unroll
              for (int tp = 0; tp < 4; ++tp) Hacc[tp] = Hacc[tp] * decl;
#pragma unroll
              for (int kk = 0; kk < 2; ++kk) { const bf16x8 af = *(const LAS bf16x8*)(BT + (w * 16 + fr) * SX + kk * 32 + fq * 8);
#pragma unroll
                  for (int tp = 0; tp < 4; ++tp) { const bf16x8 xf = *(const LAS bf16x8*)(XsT + (tp * 16 + fr) * SX + kk * 32 + fq * 8);
                      Hacc[tp] = __builtin_amdgcn_mfma_f32_16x16x32_bf16(af, xf, Hacc[tp], 0, 0, 0); } } }
            __builtin_amdgcn_s_setprio(0);
            LDS_BARRIER();
#pragma unroll
            for (int tp = 0; tp < 4; ++tp) { u32x2 o; o.x = cvt_pk_bf16(Hacc[tp][0], Hacc[tp][1]); o.y = cvt_pk_bf16(Hacc[tp][2], Hacc[tp][3]);
                *(LAS u32x2*)(Hb + (tp * 16 + fr) * SB + w * 16 + fq * 4) = o; }
            if (ci + 1 < NCH) C_STORE();
            dtcur = dtraw;
            LDS_BARRIER();
        }
#undef C_ISSUE
#undef C_STORE
    }
}

__device__ __forceinline__ void mamba_post_phase(const P& p, int l, int r0) {
    const int lane = opq_tid() & 63, wid = opq_tid() >> 6;
    const bf16_t* PM = (const bf16_t*)(p.ws + OFF_PM);
    bf16_t* Y = (bf16_t*)(p.ws + OFF_Y);
    const int ch = lane * 8;
    const float Dh = p.in[16][l * 8 + (lane >> 3)];
    const f32x4 nw0 = *(const f32x4*)(p.in[17] + l * 512 + ch), nw1 = *(const f32x4*)(p.in[17] + l * 512 + ch + 4);
    const bf16_t* XBCp = (const bf16_t*)(p.ws + OFF_HN);
    u32x4 yFA, yBA, zzA, xsA, yFB, yBB, zzB, xsB;
#define MQ_LOAD(X, row_) do { yF##X = *(const u32x4*)(Y + (size_t)(row_) * DM + ch); yB##X = *(const u32x4*)(Y + (size_t)(row_) * DM + 512 + ch); \
        zz##X = *(const u32x4*)(PM + (size_t)(row_) * PMW + ch); xs##X = *(const u32x4*)(XBCp + (size_t)(row_) * 1024 + ch); } while (0)
#define MQ_COMPUTE(X, row_) do { float y[8]; float ss = 0.f; \
        _Pragma("unroll") for (int e = 0; e < 8; ++e) { float t = bfe(yF##X, e) + bfe(yB##X, e) + Dh * bfe(xs##X, e); t *= siluf_(bfe(zz##X, e)); y[e] = t; ss += t * t; } \
        ss += __shfl_xor(ss, 1); ss += __shfl_xor(ss, 2); ss += __shfl_xor(ss, 4); ss += __shfl_xor(ss, 8); ss += __shfl_xor(ss, 16); \
        const float rstd = rsqrtf(ss * (1.f / 256.f) + EPS); u32x4 o; \
        o.x = cvt_pk_bf16(y[0] * rstd * nw0[0], y[1] * rstd * nw0[1]); o.y = cvt_pk_bf16(y[2] * rstd * nw0[2], y[3] * rstd * nw0[3]); \
        o.z = cvt_pk_bf16(y[4] * rstd * nw1[0], y[5] * rstd * nw1[1]); o.w = cvt_pk_bf16(y[6] * rstd * nw1[2], y[7] * rstd * nw1[3]); \
        *(u32x4*)(Y + (size_t)(row_) * DM + ch) = o; } while (0)
    const int rstep = (int)gridDim.x * 8;
    int row = r0 + opq_bid() * 8 + wid;
    if (row < R) MQ_LOAD(A, row);
    while (row < R) {
        int rn = row + rstep;
        if (rn < R) MQ_LOAD(B, rn);
        __builtin_amdgcn_sched_barrier(0);
        MQ_COMPUTE(A, row);
        __builtin_amdgcn_sched_barrier(0);
        row = rn; if (row >= R) break;
        rn = row + rstep;
        if (rn < R) MQ_LOAD(A, rn);
        __builtin_amdgcn_sched_barrier(0);
        MQ_COMPUTE(B, row);
        __builtin_amdgcn_sched_barrier(0);
        row = rn;
    }
#undef MQ_LOAD
#undef MQ_COMPUTE
}

template <int MM>
__device__ __forceinline__ void prep_wload(const P& p, int l, int w, int fr, int fq, const bf16_t* W2t, const bf16_t* A2t, bf16x8 (&pw)[2][4], f32x4 (&pb)[4]) {
    constexpr int d = MM & 1;
    const bf16_t* Wt = MM < 2 ? W2t + d * 512 * 64 : A2t + d * 512 * 64;
#pragma unroll
    for (int k2 = 0; k2 < 2; ++k2)
#pragma unroll
        for (int ns = 0; ns < 4; ++ns) pw[k2][ns] = *(const bf16x8*)(Wt + (size_t)(w * 64 + ns * 16 + fr) * 64 + k2 * 32 + fq * 8);
#pragma unroll
    for (int ns = 0; ns < 4; ++ns) { const int ch = w * 64 + ns * 16 + fq * 4;
        pb[ns] = MM < 2 ? *(const f32x4*)(p.in[19] + (size_t)(l * 2 + d) * 512 + ch) : *(const f32x4*)(p.in[21] + (size_t)(l * 2 + d) * 512 + ch); }
}
template <int MM, bool PRE = false>
__device__ __forceinline__ void prep_mm(const P& p, int l, int row0, int w, int fr, int fq, const LAS bf16_t* XW, const LAS bf16_t* XA, const LAS bf16_t* XG,
                                        const bf16_t* W2t, const bf16_t* A2t, const bf16_t* G2t, bf16_t* D4, bf16_t* G, const bf16x8 (*pw)[4] = nullptr, const f32x4* pb = nullptr) {
    constexpr int LX = 72, LG = 168, TT = 48, NTS = TT / 16;
    constexpr int d = MM & 1, K = MM < 4 ? 64 : 160, LDX = MM < 4 ? LX : LG, NK = K / 32;
    const LAS bf16_t* X = MM < 2 ? XW + d * TT * LX : (MM < 4 ? XA + d * TT * LX : XG);
    const bf16_t* Wt = MM < 2 ? W2t + d * 512 * 64 : (MM < 4 ? A2t + d * 512 * 64 : G2t);
    f32x4 bias[4];
#pragma unroll
    for (int ns = 0; ns < 4; ++ns) { const int ch = w * 64 + ns * 16 + fq * 4;
        if (PRE) bias[ns] = pb[ns];
        else bias[ns] = MM < 2 ? *(const f32x4*)(p.in[19] + (size_t)(l * 2 + d) * 512 + ch) : (MM < 4 ? *(const f32x4*)(p.in[21] + (size_t)(l * 2 + d) * 512 + ch) : (f32x4){0.f, 0.f, 0.f, 0.f}); }
    f32x4 acc[NTS][4];
#pragma unroll
    for (int a = 0; a < NTS; ++a)
#pragma unroll
        for (int c = 0; c < 4; ++c) acc[a][c] = (f32x4){0.f, 0.f, 0.f, 0.f};
#pragma unroll
    for (int k0 = 0; k0 < NK; k0 += 2) {
        bf16x8 af[2][4], bfr[2][NTS];
#pragma unroll
        for (int k2 = 0; k2 < 2; ++k2) if (k0 + k2 < NK) {
#pragma unroll
            for (int ns = 0; ns < 4; ++ns) { if (PRE) af[k2][ns] = pw[k0 + k2][ns]; else af[k2][ns] = *(const bf16x8*)(Wt + (size_t)(w * 64 + ns * 16 + fr) * K + (k0 + k2) * 32 + fq * 8); }
#pragma unroll
            for (int ts = 0; ts < NTS; ++ts) bfr[k2][ts] = *(const LAS bf16x8*)(X + (ts * 16 + fr) * LDX + (k0 + k2) * 32 + fq * 8); }
#pragma unroll
        for (int k2 = 0; k2 < 2; ++k2) if (k0 + k2 < NK) {
#pragma unroll
            for (int ts = 0; ts < NTS; ++ts)
#pragma unroll
                for (int ns = 0; ns < 4; ++ns) acc[ts][ns] = __builtin_amdgcn_mfma_f32_16x16x32_bf16(af[k2][ns], bfr[k2][ts], acc[ts][ns], 0, 0, 0); }
    }
#pragma unroll
    for (int ts = 0; ts < NTS; ++ts)
#pragma unroll
        for (int ns = 0; ns < 4; ++ns) {
            const int row = row0 + ts * 16 + fr, ch = w * 64 + ns * 16 + fq * 4;
            f32x4 v = acc[ts][ns];
            if (MM < 2) {
#pragma unroll
                for (int e = 0; e < 4; ++e) v[e] = -0.6065306597126334f * sigmoidf_(bias[ns][e] + v[e]); }
            else if (MM < 4) {
#pragma unroll
                for (int e = 0; e < 4; ++e) v[e] = sigmoidf_(bias[ns][e] + v[e]); }
            u32x2 o; o.x = cvt_pk_bf16(v[0], v[1]); o.y = cvt_pk_bf16(v[2], v[3]);
            bf16_t* dst = MM < 2 ? D4 + (size_t)row * 2048 + d * 512 + ch : (MM < 4 ? D4 + (size_t)row * 2048 + 1024 + d * 512 + ch : G + (size_t)row * 512 + ch);
            *(u32x2*)dst = o;
        }
}
__device__ __forceinline__ void rwkv_prep_phase(LAS unsigned char* lds, const P& p, int l) {
    constexpr int LX = 72, LG = 168, NIT = 4, TT = 48;
    LAS bf16_t* XW = (LAS bf16_t*)lds;
    LAS bf16_t* XA = XW + 2 * TT * LX;
    LAS bf16_t* XG = XA + 2 * TT * LX;
    const int tid = opq_tid(), lane = tid & 63, w = tid >> 6, fr = lane & 15, fq = lane >> 4;
    const bf16_t* PR = (const bf16_t*)(p.ws + OFF_PR);
    bf16_t* D4 = (bf16_t*)(p.ws + OFF_D4); bf16_t* G = (bf16_t*)(p.ws + OFF_G);
    const bf16_t* W2t = (const bf16_t*)(p.ws + OFF_LORA); const bf16_t* A2t = W2t + 2 * 512 * 64; const bf16_t* G2t = A2t + 2 * 512 * 64;
    const float* mu = p.in[18] + (size_t)l * RCOLS;
    for (int tile = opq_bid(); tile < R / TT; tile += gridDim.x) {
        const int row0 = tile * TT;
        bf16x8 wA[2][4], wB[2][4]; f32x4 bA[4], bB[4];
        prep_wload<0>(p, l, w, fr, fq, W2t, A2t, wA, bA);
        __syncthreads();
#pragma unroll 1
        for (int bi = 0; bi < 2; ++bi) {
        u32x4 cu[NIT], pv[NIT], nv[NIT];
#pragma unroll
        for (int i = 0; i < NIT; ++i) {
            const int it = tid + (bi * NIT + i) * 512; const bool valid = it < TT * 52;
            const int j = it / 52, cgi = it % 52, row = row0 + j, col = 1536 + cgi * 8;
            int first, last, mrow; row_info(row, first, last, mrow);
            const u32x4 z4 = (u32x4){0u, 0u, 0u, 0u};
            if (valid) { const bf16_t* src = PR + (size_t)row * PRW + col;
                cu[i] = *(const u32x4*)src; pv[i] = first ? z4 : *(const u32x4*)(src - PRW); nv[i] = last ? z4 : *(const u32x4*)(src + PRW); }
            else { cu[i] = z4; pv[i] = z4; nv[i] = z4; }
        }
#pragma unroll
        for (int i = 0; i < NIT; ++i) {
            const int it = tid + (bi * NIT + i) * 512; const bool valid = it < TT * 52;
            const int j = it / 52, cgi = it % 52;
            const f32x4 m0 = *(const f32x4*)(mu + 1536 + cgi * 8), m1 = *(const f32x4*)(mu + 1536 + cgi * 8 + 4);
            float s[8];
#pragma unroll
            for (int e = 0; e < 8; ++e) { const float u = bfe(cu[i], e); const float mm_ = e < 4 ? m0[e & 3] : m1[e & 3]; s[e] = u + mm_ * (0.5f * (bfe(pv[i], e) + bfe(nv[i], e)) - u); }
            LAS bf16_t* dst;
            if (cgi < 16) { const int d = cgi >> 3, kk = (cgi & 7) * 8; dst = XW + (d * TT + j) * LX + kk;
#pragma unroll
                for (int e = 0; e < 8; ++e) s[e] = tanhf_(s[e]); }
            else if (cgi < 32) { const int c2 = cgi - 16, d = c2 >> 3, kk = (c2 & 7) * 8; dst = XA + (d * TT + j) * LX + kk; }
            else { const int kk = (cgi - 32) * 8; dst = XG + j * LG + kk;
#pragma unroll
                for (int e = 0; e < 8; ++e) s[e] = sigmoidf_(s[e]); }
            u32x4 o; o.x = cvt_pk_bf16(s[0], s[1]); o.y = cvt_pk_bf16(s[2], s[3]); o.z = cvt_pk_bf16(s[4], s[5]); o.w = cvt_pk_bf16(s[6], s[7]);
            if (valid) *(LAS u32x4*)dst = o;
        }
        }
        __syncthreads();
        prep_wload<1>(p, l, w, fr, fq, W2t, A2t, wB, bB);
        prep_mm<0, true>(p, l, row0, w, fr, fq, XW, XA, XG, W2t, A2t, G2t, D4, G, wA, bA);
        prep_wload<2>(p, l, w, fr, fq, W2t, A2t, wA, bA);
        prep_mm<1, true>(p, l, row0, w, fr, fq, XW, XA, XG, W2t, A2t, G2t, D4, G, wB, bB);
        prep_wload<3>(p, l, w, fr, fq, W2t, A2t, wB, bB);
        prep_mm<2, true>(p, l, row0, w, fr, fq, XW, XA, XG, W2t, A2t, G2t, D4, G, wA, bA);
        prep_mm<3, true>(p, l, row0, w, fr, fq, XW, XA, XG, W2t, A2t, G2t, D4, G, wB, bB);
        prep_mm<4>(p, l, row0, w, fr, fq, XW, XA, XG, W2t, A2t, G2t, D4, G);
    }
}

__device__ __forceinline__ void rwkv_scan_phase(LAS unsigned char* lds, const P& p, int l) {
    constexpr int T = 32, NCH = (CTX + SEQ) / T, BUF = 6 * T * 64;
    LAS float* base = (LAS float*)lds;
    LAS float* ob = base + 2 * BUF;
    const int tid = opq_tid();
    const bf16_t* PR = (const bf16_t*)(p.ws + OFF_PR);
    bf16_t* D4 = (bf16_t*)(p.ws + OFF_D4);
    const float* mu = p.in[18] + (size_t)l * RCOLS;
    for (int q = opq_bid(); q < 256; q += gridDim.x) {
        const int b = q >> 4, h = (q >> 1) & 7, dir = q & 1;
        const int vv_ = tid >> 3, part = tid & 7;
        f32x2 S2[2][4];
#pragma unroll
        for (int i = 0; i < 4; ++i) { S2[0][i] = (f32x2){0.f, 0.f}; S2[1][i] = (f32x2){0.f, 0.f}; }
        const int w = tid >> 6, rp = (tid >> 3) & 31;
        const int lj = tid >> 4, c4 = (tid & 15) * 4, hc = h * 64 + c4;
        f32x4 mur, muk, muv, kkw, kaw, rkw;
#pragma unroll
        for (int e = 0; e < 4; ++e) { mur[e] = mu[hc + e]; muk[e] = mu[512 + hc + e]; muv[e] = mu[1024 + hc + e];
            kkw[e] = p.in[24][l * 512 + hc + e]; kaw[e] = p.in[25][l * 512 + hc + e]; rkw[e] = p.in[26][l * 512 + hc + e]; }
        float* BON = (float*)(p.ws + OFF_DT);
        u32x2 lrA[3], lkA[3], lvA[3], llwA, laA, lrB[3], lkB[3], lvB[3], llwB, laB;
#define R_ISSUE(ci, LJ, X) do { int row, first, last; seqpos((ci) * T + (LJ), dir, b, row, first, last); const u32x2 z2 = (u32x2){0u, 0u}; \
            const bf16_t* src = PR + (size_t)row * PRW + hc; \
            lr##X[1] = *(const u32x2*)src; lk##X[1] = *(const u32x2*)(src + 512); lv##X[1] = *(const u32x2*)(src + 1024); \
            if (first) { lr##X[0] = z2; lk##X[0] = z2; lv##X[0] = z2; } else { lr##X[0] = *(const u32x2*)(src - PRW); lk##X[0] = *(const u32x2*)(src - PRW + 512); lv##X[0] = *(const u32x2*)(src - PRW + 1024); } \
            if (last) { lr##X[2] = z2; lk##X[2] = z2; lv##X[2] = z2; } else { lr##X[2] = *(const u32x2*)(src + PRW); lk##X[2] = *(const u32x2*)(src + PRW + 512); lv##X[2] = *(const u32x2*)(src + PRW + 1024); } \
            llw##X = *(const u32x2*)(D4 + (size_t)row * 2048 + dir * 512 + hc); la##X = *(const u32x2*)(D4 + (size_t)row * 2048 + 1024 + dir * 512 + hc); } while (0)
#define R_PROCESS(ci, LJ, X) do { LAS float* bb = base + ((ci) & 1) * BUF + (LJ) * 64 + c4; \
            f32x4 rr, kx, vx, kkv, av, wv; float ss = 0.f; \
            _Pragma("unroll") for (int e = 0; e < 4; ++e) { \
                const float ur = bfe2(lr##X[1], e), uk = bfe2(lk##X[1], e), uv = bfe2(lv##X[1], e); \
                rr[e] = ur + mur[e] * (0.5f * (bfe2(lr##X[0], e) + bfe2(lr##X[2], e)) - ur); \
                kx[e] = uk + muk[e] * (0.5f * (bfe2(lk##X[0], e) + bfe2(lk##X[2], e)) - uk); \
                vx[e] = uv + muv[e] * (0.5f * (bfe2(lv##X[0], e) + bfe2(lv##X[2], e)) - uv); \
                kkv[e] = kx[e] * kkw[e]; ss += kkv[e] * kkv[e]; av[e] = bfe2(la##X, e); wv[e] = __expf(bfe2(llw##X, e)); } \
            ss = red16(ss); \
            const float inv = 1.f / fmaxf(sqrtf(ss), 1e-12f); \
            f32x4 bv, kdv, nkk; \
            float bsum = 0.f; \
            _Pragma("unroll") for (int e = 0; e < 4; ++e) { kkv[e] *= inv; bv[e] = kkv[e] * av[e]; nkk[e] = -kkv[e]; kdv[e] = kx[e] * (1.f + (av[e] - 1.f) * kaw[e]); bsum += rr[e] * kdv[e] * rkw[e]; } \
            bsum = red16(bsum); \
            if ((tid & 15) == 0) { int row_, f_, l_; seqpos((ci) * T + (LJ), dir, b, row_, f_, l_); BON[((size_t)dir * R + row_) * 8 + h] = bsum; } \
            *(LAS f32x4*)(bb + 0 * T * 64) = wv; *(LAS f32x4*)(bb + 1 * T * 64) = bv; *(LAS f32x4*)(bb + 2 * T * 64) = kdv; \
            *(LAS f32x4*)(bb + 3 * T * 64) = nkk; *(LAS f32x4*)(bb + 4 * T * 64) = rr; *(LAS f32x4*)(bb + 5 * T * 64) = vx; } while (0)
#define R_FLUSH(cc, LJ) do { int row, first, last; seqpos((cc) * T + (LJ), dir, b, row, first, last); \
            const f32x4 ov = *(const LAS f32x4*)(ob + ((cc) & 1) * T * 64 + (LJ) * 64 + c4); \
            u32x2 o2; o2.x = cvt_pk_bf16(ov[0], ov[1]); o2.y = cvt_pk_bf16(ov[2], ov[3]); \
            *(u32x2*)(D4 + (size_t)row * 2048 + dir * 512 + hc) = o2; } while (0)
        const int ljA = (tid - 256) >> 4, ljB = ljA + 16;
        __syncthreads();
        R_ISSUE(0, lj, A); R_PROCESS(0, lj, A);
        __syncthreads();
        for (int ci = 0; ci < NCH; ++ci) {
            const LAS float* cb = base + (ci & 1) * BUF;
            LAS float* obw = ob + (ci & 1) * T * 64;
            if (w < 4) {
#define RV_LOAD(P_, j_) do { const LAS float* pj = cb + (j_) * 64 + part * 4; \
                P_##w0 = *(const LAS f32x4*)(pj); P_##w1 = *(const LAS f32x4*)(pj + 32); \
                P_##b0 = *(const LAS f32x4*)(pj + T * 64); P_##b1 = *(const LAS f32x4*)(pj + T * 64 + 32); \
                P_##k0 = *(const LAS f32x4*)(pj + 2 * T * 64); P_##k1 = *(const LAS f32x4*)(pj + 2 * T * 64 + 32); \
                P_##n0 = *(const LAS f32x4*)(pj + 3 * T * 64); P_##n1 = *(const LAS f32x4*)(pj + 3 * T * 64 + 32); \
                P_##r0 = *(const LAS f32x4*)(pj + 4 * T * 64); P_##r1 = *(const LAS f32x4*)(pj + 4 * T * 64 + 32); \
                P_##vt = *(const LAS f32x2*)(cb + 5 * T * 64 + (j_) * 64 + rp * 2); } while (0)
#define RV_V4(x_) {(f32x2){x_##0[0], x_##0[1]}, (f32x2){x_##0[2], x_##0[3]}, (f32x2){x_##1[0], x_##1[1]}, (f32x2){x_##1[2], x_##1[3]}}
#define RV_COMPUTE(P_, jj_) do { const f32x2 w_[4] = RV_V4(P_##w), b_[4] = RV_V4(P_##b), k_[4] = RV_V4(P_##k), n_[4] = RV_V4(P_##n), r_[4] = RV_V4(P_##r); \
                _Pragma("unroll") for (int u = 0; u < 2; ++u) { \
                    f32x2 sa2 = S2[u][0] * n_[0]; sa2 = S2[u][1] * n_[1] + sa2; sa2 = S2[u][2] * n_[2] + sa2; sa2 = S2[u][3] * n_[3] + sa2; \
                    const float sa = red8(sa2[0] + sa2[1]); \
                    const f32x2 sav = (f32x2){sa, sa}, vtv = (f32x2){P_##vt[u], P_##vt[u]}; \
                    f32x2 o2 = (f32x2){0.f, 0.f}; \
                    _Pragma("unroll") for (int q2 = 0; q2 < 4; ++q2) { f32x2 t = vtv * k_[q2]; t = sav * b_[q2] + t; S2[u][q2] = S2[u][q2] * w_[q2] + t; o2 = S2[u][q2] * r_[q2] + o2; } \
                    const float o = red8(o2[0] + o2[1]); \
                    if (part == (jj_)) ocap[u] = o; } } while (0)
                f32x4 Aw0, Aw1, Ab0, Ab1, Ak0, Ak1, An0, An1, Ar0, Ar1, Bw0, Bw1, Bb0, Bb1, Bk0, Bk1, Bn0, Bn1, Br0, Br1; f32x2 Avt, Bvt;
                __builtin_amdgcn_s_setprio(3);
                RV_LOAD(A, 0);
#pragma unroll 1
                for (int j0 = 0; j0 < T; j0 += 8) {
                    f32x2 ocap = (f32x2){0.f, 0.f};
#pragma unroll
                    for (int jj = 0; jj < 8; jj += 2) {
                        RV_LOAD(B, j0 + jj + 1);
                        __builtin_amdgcn_sched_barrier(0);
                        RV_COMPUTE(A, jj);
                        __builtin_amdgcn_sched_barrier(0);
                        if (j0 + jj + 2 < T) RV_LOAD(A, j0 + jj + 2);
                        __builtin_amdgcn_sched_barrier(0);
                        RV_COMPUTE(B, jj + 1);
                        __builtin_amdgcn_sched_barrier(0);
                    }
                    *(LAS f32x2*)(obw + (j0 + part) * 64 + rp * 2) = ocap;
                }
                __builtin_amdgcn_s_setprio(0);
#undef RV_LOAD
#undef RV_V4
#undef RV_COMPUTE
            }
            else {
                if (ci + 1 < NCH) { R_ISSUE(ci + 1, ljA, A); R_ISSUE(ci + 1, ljB, B); }
                if (ci > 0) { R_FLUSH(ci - 1, ljA); R_FLUSH(ci - 1, ljB); }
                if (ci + 1 < NCH) { R_PROCESS(ci + 1, ljA, A); R_PROCESS(ci + 1, ljB, B); }
            }
            LDS_BARRIER();
        }
        if (w >= 4) { R_FLUSH(NCH - 1, ljA); R_FLUSH(NCH - 1, ljB); }
#undef R_FLUSH
#undef R_ISSUE
#undef R_PROCESS
    }
}

__device__ __forceinline__ void rwkv_post_phase(const P& p, int l, int r0) {
    const int lane = opq_tid() & 63, wid = opq_tid() >> 6;
    const bf16_t* PR = (const bf16_t*)(p.ws + OFF_PR);
    const bf16_t* D4 = (const bf16_t*)(p.ws + OFF_D4); const bf16_t* G = (const bf16_t*)(p.ws + OFF_G);
    bf16_t* Y = (bf16_t*)(p.ws + OFF_Y);
    const float* mu = p.in[18] + (size_t)l * RCOLS;
    const int ch = lane * 8;
    float mur[8], muk[8], muv[8], kaw[8], rkw[8], lnw[8], lnb[8];
#pragma unroll
    for (int hh = 0; hh < 2; ++hh) {
        const f32x4 a0 = *(const f32x4*)(mu + ch + hh * 4), a1 = *(const f32x4*)(mu + 512 + ch + hh * 4), a2 = *(const f32x4*)(mu + 1024 + ch + hh * 4);
        const f32x4 a3 = *(const f32x4*)(p.in[25] + l * 512 + ch + hh * 4), a4 = *(const f32x4*)(p.in[26] + l * 512 + ch + hh * 4);
        const f32x4 a5 = *(const f32x4*)(p.in[27] + l * 512 + ch + hh * 4), a6 = *(const f32x4*)(p.in[28] + l * 512 + ch + hh * 4);
#pragma unroll
        for (int e = 0; e < 4; ++e) { mur[hh * 4 + e] = a0[e]; muk[hh * 4 + e] = a1[e]; muv[hh * 4 + e] = a2[e]; kaw[hh * 4 + e] = a3[e]; rkw[hh * 4 + e] = a4[e]; lnw[hh * 4 + e] = a5[e]; lnb[hh * 4 + e] = a6[e]; }
    }
    const float* BON = (const float*)(p.ws + OFF_DT);
    const u32x4 z4 = (u32x4){0u, 0u, 0u, 0u};
    u32x4 vcA, vpA, vnA, oFA, oBA, ggA, vcB, vpB, vnB, oFB, oBB, ggB; float b0A, b1A, b0B, b1B; int flA = 0, flB = 0;
#define RQ_LOAD(X, row_) do { int f_, l_, m_; row_info(row_, f_, l_, m_); const bf16_t* src = PR + (size_t)(row_) * PRW + 1024 + ch; \
        vc##X = *(const u32x4*)src; vp##X = *(const u32x4*)(src - (f_ ? 0 : PRW)); vn##X = *(const u32x4*)(src + (l_ ? 0 : PRW)); fl##X = f_ | (l_ << 1); \
        const bf16_t* d4 = D4 + (size_t)(row_) * 2048 + ch; oF##X = *(const u32x4*)d4; oB##X = *(const u32x4*)(d4 + 512); \
        gg##X = *(const u32x4*)(G + (size_t)(row_) * 512 + ch); \
        b0##X = BON[(size_t)(row_) * 8 + (lane >> 3)]; b1##X = BON[((size_t)R + (row_)) * 8 + (lane >> 3)]; } while (0)
#define RQ_COMPUTE(X, row_) do { const float bs = b0##X + b1##X; float o[8], vx[8]; float sum = 0.f; const u32x4 vp_ = (fl##X & 1) ? z4 : vp##X, vn_ = (fl##X & 2) ? z4 : vn##X; \
        _Pragma("unroll") for (int e = 0; e < 8; ++e) { const float uv = bfe(vc##X, e); \
            vx[e] = uv + muv[e] * (0.5f * (bfe(vp_, e) + bfe(vn_, e)) - uv); o[e] = bfe(oF##X, e) + bfe(oB##X, e); sum += o[e]; } \
        sum = red8(sum); const float mean = sum * (1.f / 64.f); float var = 0.f; \
        _Pragma("unroll") for (int e = 0; e < 8; ++e) { o[e] -= mean; var += o[e] * o[e]; } \
        var = red8(var); const float rstd = rsqrtf(var * (1.f / 64.f) + 64e-5f); float out[8]; \
        _Pragma("unroll") for (int e = 0; e < 8; ++e) { const float on = o[e] * rstd * lnw[e] + lnb[e]; out[e] = (on + bs * vx[e]) * bfe(gg##X, e); } \
        u32x4 w; w.x = cvt_pk_bf16(out[0], out[1]); w.y = cvt_pk_bf16(out[2], out[3]); w.z = cvt_pk_bf16(out[4], out[5]); w.w = cvt_pk_bf16(out[6], out[7]); \
        *(u32x4*)(Y + (size_t)(row_) * DM + 512 + ch) = w; } while (0)
    const int rstep = (int)gridDim.x * 8;
    int row = r0 + opq_bid() * 8 + wid;
    if (row < R) RQ_LOAD(A, row);
    while (row < R) {
        int rn = row + rstep;
        if (rn < R) RQ_LOAD(B, rn);
        __builtin_amdgcn_sched_barrier(0);
        RQ_COMPUTE(A, row);
        __builtin_amdgcn_sched_barrier(0);
        row = rn; if (row >= R) break;
        rn = row + rstep;
        if (rn < R) RQ_LOAD(A, rn);
        __builtin_amdgcn_sched_barrier(0);
        RQ_COMPUTE(B, row);
        __builtin_amdgcn_sched_barrier(0);
        row = rn;
    }
#undef RQ_LOAD
#undef RQ_COMPUTE
}

__device__ __forceinline__ void gate_phase(const P& p, int l, int r0, int gvbase) {
    bf16_t* GV = (bf16_t*)(p.ws + OFF_GV);
    const float* cwt = p.in[30] + (size_t)l * 9 * DFF; const float* cbs = p.in[31] + (size_t)l * DFF;
    const int nstrip_ctx = (r0 < RC) ? RC / 16 : 0, nstrip = nstrip_ctx + RL / 16;
    const int gthr = opq_bid() * 512 + opq_tid(), nslots = ((int)gridDim.x * 512) / 352;
    const int c8 = (gthr % 352) * 8, s0 = gthr / 352;
    f32x4 wa[9], wb[9];
#pragma unroll
    for (int k = 0; k < 9; ++k) { wa[k] = *(const f32x4*)(cwt + (size_t)k * DFF + c8); wb[k] = *(const f32x4*)(cwt + (size_t)k * DFF + c8 + 4); }
    const f32x4 ba = *(const f32x4*)(cbs + c8), bb = *(const f32x4*)(cbs + c8 + 4);
    for (int sid = (s0 < nslots ? s0 : nstrip); sid < nstrip; sid += nslots) {
        int row0, Wd, Hh, yy, x0;
        if (sid < nstrip_ctx) { row0 = sid * 16; Wd = CTX; Hh = 1; yy = 0; x0 = row0 & (CTX - 1); }
        else { const int r2 = (sid - nstrip_ctx) * 16; row0 = RC + r2; Wd = 64; Hh = 32; const int t = r2 & (SEQ - 1); yy = t >> 6; x0 = t & 63; }
        const bool vup = (yy > 0), vdn = (yy + 1 < Hh);
        const bf16_t* gp = GV + (size_t)(row0 - gvbase) * NUP + c8;
        const u32x4 z4 = (u32x4){0u, 0u, 0u, 0u};
        const long upo = vup ? -(long)Wd * NUP : 0, dno = vdn ? (long)Wd * NUP : 0;
        u32x4 L[3], C[3], Rr[3], Nn[3];
#define G_COL(dst, dx, ok) do { const bool _ok = (ok); const bf16_t* q = gp + (long)(_ok ? (dx) : 0) * NUP; \
            const u32x4 _a = *(const u32x4*)(q + upo), _b = *(const u32x4*)q, _c = *(const u32x4*)(q + dno); \
            dst[0] = (_ok && vup) ? _a : z4; dst[1] = _ok ? _b : z4; dst[2] = (_ok && vdn) ? _c : z4; } while (0)
        G_COL(L, -1, x0 > 0); G_COL(C, 0, true); G_COL(Rr, 1, x0 + 1 < Wd);
        u32x4 vv = *(const u32x4*)(gp + DFF), vvn = z4;
#pragma unroll
        for (int i = 0; i < 16; ++i) {
            if (i + 2 <= 16) G_COL(Nn, i + 2, x0 + i + 2 < Wd);
            if (i + 1 < 16) vvn = *(const u32x4*)(gp + (long)(i + 1) * NUP + DFF);
            float acc[8];
#pragma unroll
            for (int e = 0; e < 4; ++e) { acc[e] = ba[e]; acc[4 + e] = bb[e]; }
#pragma unroll
            for (int ky = 0; ky < 3; ++ky)
#pragma unroll
                for (int e = 0; e < 4; ++e) {
                    acc[e] += wa[ky * 3 + 0][e] * bfe(L[ky], e) + wa[ky * 3 + 1][e] * bfe(C[ky], e) + wa[ky * 3 + 2][e] * bfe(Rr[ky], e);
                    acc[4 + e] += wb[ky * 3 + 0][e] * bfe(L[ky], 4 + e) + wb[ky * 3 + 1][e] * bfe(C[ky], 4 + e) + wb[ky * 3 + 2][e] * bfe(Rr[ky], 4 + e); }
            float o[8];
#pragma unroll
            for (int e = 0; e < 8; ++e) { const float x = acc[e]; const float u2 = 1.5957691216057308f * (x + 0.044715f * x * x * x);
                o[e] = x * __builtin_amdgcn_rcpf(1.f + __expf(-u2)) * bfe(vv, e); }
            u32x4 w; w.x = cvt_pk_bf16(o[0], o[1]); w.y = cvt_pk_bf16(o[2], o[3]); w.z = cvt_pk_bf16(o[4], o[5]); w.w = cvt_pk_bf16(o[6], o[7]);
            *(u32x4*)(GV + (size_t)(row0 + i - gvbase) * NUP + DFF + c8) = w;
#pragma unroll
            for (int ky = 0; ky < 3; ++ky) { L[ky] = C[ky]; C[ky] = Rr[ky]; Rr[ky] = Nn[ky]; }
            vv = vvn;
        }
#undef G_COL
    }
}

__global__ void __launch_bounds__(512, 2) fwd_megakernel(P p) {
    extern __shared__ __attribute__((aligned(16))) unsigned char lds_raw[];
    LAS unsigned char* lds = (LAS unsigned char*)lds_raw;
    cg::grid_group grid = cg::this_grid();
    unsigned char* ws = p.ws;
    float* ctxres = (float*)(ws + OFF_CTX);
    bf16_t* HN = (bf16_t*)(ws + OFF_HN); bf16_t* HN2 = (bf16_t*)(ws + OFF_HN2);
    bf16_t* PMp = (bf16_t*)(ws + OFF_PM); bf16_t* PRp = (bf16_t*)(ws + OFF_PR); float* DTp = (float*)(ws + OFF_DT);
    bf16_t* Yp = (bf16_t*)(ws + OFF_Y); bf16_t* MRAW = (bf16_t*)(ws + OFF_MRAW); bf16_t* GV = (bf16_t*)(ws + OFF_GV);
    const bf16_t* WIN = (const bf16_t*)(ws + OFF_WIN); const bf16_t* WOUT = (const bf16_t*)(ws + OFF_WOUT);
    const bf16_t* WUP = (const bf16_t*)(ws + OFF_WUP); const bf16_t* WDN = (const bf16_t*)(ws + OFF_WDN);
    const int G = gridDim.x, c = blockIdx.x;
    volatile LAS unsigned* xst = (volatile LAS unsigned*)(lds + 131072);
    if (threadIdx.x < 2) xst[threadIdx.x] = 0u;
    __syncthreads();
    (void)xcd_barrier_post((unsigned*)(ws + OFF_BAR), xst);

    mod_phase(lds, p);
    convert_weights(lds, p, 0);
    grid.sync();
    row_phase<false, true>(p, 0, 0, 0, R, p.in[0], p.in[2], nullptr, 0, 0, nullptr, 0, nullptr, nullptr, p.in[6], 0, HN, 0);
    xcd_barrier((unsigned*)(ws + OFF_BAR), (volatile LAS unsigned*)(lds + 131072));
#pragma unroll 1
    for (int l = 0; l < 2; ++l) {
        const float* xlat = l == 0 ? p.in[0] : p.out;
        const float* xctx = l == 0 ? p.in[2] : ctxres;
        { pg8::Gemm g{HN, WIN, R, NIN, DM, DM}; pg8::StaticOrder S; S.init(R, NIN, G, c, WGM_IN); pg8::EpiInProj E{PMp, PRp, DTp}; pg8::gemm_phase(lds, g, S, E); }
        xcd_barrier((unsigned*)(ws + OFF_BAR), (volatile LAS unsigned*)(lds + 131072));
        xbc_phase(p, l);
        xcd_barrier((unsigned*)(ws + OFF_BAR), (volatile LAS unsigned*)(lds + 131072));
        mamba_chunk_phase(lds, p, l);
        xcd_barrier((unsigned*)(ws + OFF_BAR), (volatile LAS unsigned*)(lds + 131072));
        mamba_post_phase(p, l, l == 0 ? 0 : RC);
        xcd_barrier((unsigned*)(ws + OFF_BAR), (volatile LAS unsigned*)(lds + 131072));
        rwkv_prep_phase(lds, p, l);
        xcd_barrier((unsigned*)(ws + OFF_BAR), (volatile LAS unsigned*)(lds + 131072));
        rwkv_scan_phase(lds, p, l);
        xcd_barrier((unsigned*)(ws + OFF_BAR), (volatile LAS unsigned*)(lds + 131072));
        rwkv_post_phase(p, l, l == 0 ? 0 : RC);
        xcd_barrier((unsigned*)(ws + OFF_BAR), (volatile LAS unsigned*)(lds + 131072));
        const int rs = l == 0 ? 0 : RC;
        { pg8::Gemm g{Yp + (size_t)rs * DM, WOUT, R - rs, DM, DM, DM}; pg8::StaticOrder S; S.init(R - rs, DM, G, c, WGM_OUT); pg8::EpiStore E{MRAW + (size_t)rs * DM, DM}; pg8::gemm_phase(lds, g, S, E); }
        xcd_barrier((unsigned*)(ws + OFF_BAR), (volatile LAS unsigned*)(lds + 131072));
        const int nrange = l == 0 ? 2 : 1;
        const int f0 = rs, f1 = l == 0 ? 32768 : R;
        row_phase<true, true>(p, l, l, f0, f1, xlat, xctx, MRAW, DM, 0, p.in[7] + l * DM, 2048, p.out, ctxres, p.in[8] + l * DM, 3072, HN2, f0);
        if (f1 < R) row_phase<true, false>(p, l, l, f1, R, xlat, xctx, MRAW, DM, 0, p.in[7] + l * DM, 2048, p.out, ctxres, nullptr, 0, nullptr, 0);
        xcd_barrier((unsigned*)(ws + OFF_BAR), (volatile LAS unsigned*)(lds + 131072));
        for (int ri = 0; ri < nrange; ++ri) {
            const int a0 = ri == 0 ? f0 : f1, a1 = ri == 0 ? f1 : R;
            if (ri > 0) {
                row_phase<false, true>(p, l, l, a0, a1, p.out, ctxres, nullptr, 0, 0, nullptr, 0, nullptr, nullptr, p.in[8] + l * DM, 3072, HN2, a0);
                xcd_barrier((unsigned*)(ws + OFF_BAR), (volatile LAS unsigned*)(lds + 131072));
            }
            { pg8::Gemm g{HN2, WUP, a1 - a0, NUP, DM, DM}; pg8::StaticOrder S; S.init(a1 - a0, NUP, G, c, WGM_UP); pg8::EpiStore E{GV + (size_t)(a0 - rs) * NUP, NUP}; pg8::gemm_phase(lds, g, S, E); }
            xcd_barrier((unsigned*)(ws + OFF_BAR), (volatile LAS unsigned*)(lds + 131072));
        }
        gate_phase(p, l, rs, rs);
        xcd_barrier((unsigned*)(ws + OFF_BAR), (volatile LAS unsigned*)(lds + 131072));
        { pg8::Gemm g{GV + DFF, WDN, R - rs, DM, DFF, NUP}; pg8::StaticOrder S; S.init(R - rs, DM, G, c, WGM_DN); pg8::EpiStore E{GV, NUP}; pg8::gemm_phase(lds, g, S, E); }
        xcd_barrier((unsigned*)(ws + OFF_BAR), (volatile LAS unsigned*)(lds + 131072));
        if (l == 0) {
            convert_weights(lds, p, 1);
            row_phase<true, false>(p, 0, 0, 0, R, p.out, ctxres, GV, NUP, 0, p.in[9], 5120, p.out, ctxres, nullptr, 0, nullptr, 0);
            xcd_barrier((unsigned*)(ws + OFF_BAR), (volatile LAS unsigned*)(lds + 131072));
            row_phase<false, true>(p, 1, 1, 0, R, p.out, ctxres, nullptr, 0, 0, nullptr, 0, nullptr, nullptr, p.in[6] + DM, 0, HN, 0);
            xcd_barrier((unsigned*)(ws + OFF_BAR), (volatile LAS unsigned*)(lds + 131072));
        } else {
            row_phase<true, false>(p, 1, 1, RC, R, p.out, ctxres, GV, NUP, RC, p.in[9] + DM, 5120, p.out, ctxres, nullptr, 0, nullptr, 0);
        }
    }
}

extern "C" void kernel_launch(void* const* d_in, const int* in_sizes, int n_in, void* d_out, int out_size, void* d_ws, size_t ws_size, hipStream_t stream) {
    static int grid_blocks = 0;
    if (grid_blocks == 0) {
        if (n_in != 33 || ws_size < WS_NEED) { fprintf(stderr, "kernel_launch: unexpected n_in %d or ws_size %zu (< %zu)\n", n_in, ws_size, (size_t)WS_NEED); grid_blocks = -1; return; }
        int dev = 0, cus = 0, per_cu = 0;
        hipGetDevice(&dev);
        hipDeviceGetAttribute(&cus, hipDeviceAttributeMultiprocessorCount, dev);
        hipFuncSetAttribute((const void*)fwd_megakernel, hipFuncAttributeMaxDynamicSharedMemorySize, LDS_BYTES);
        hipOccupancyMaxActiveBlocksPerMultiprocessor(&per_cu, (const void*)fwd_megakernel, 512, LDS_BYTES);
        if (per_cu < 1) { fprintf(stderr, "kernel_launch: occupancy query says %d blocks per CU\n", per_cu); per_cu = 1; }
        grid_blocks = cus * 1;
        fprintf(stderr, "kernel_launch: cus %d per_cu %d grid %d ws %zu\n", cus, per_cu, grid_blocks, ws_size);
    }
    if (grid_blocks < 0) return;
    P p{};
    for (int i = 0; i < 33; ++i) p.in[i] = (const float*)d_in[i];
    p.out = (float*)d_out; p.ws = (unsigned char*)d_ws;
    hipMemsetAsync((unsigned char*)d_ws + OFF_BAR, 0, XCD_BAR_WORDS * 4, stream);
    void* args[] = {&p};
    hipError_t e = hipLaunchCooperativeKernel((const void*)fwd_megakernel, dim3(grid_blocks), dim3(512), args, LDS_BYTES, stream);
    if (e != hipSuccess) fprintf(stderr, "cooperative launch failed: %s (grid %d)\n", hipGetErrorString(e), grid_blocks);
}
```
